# Optimizing an MI355X kernel written in HIP

```python
import math
import jax
import jax.numpy as jnp
from jax import lax
import numpy as np

D_MODEL = 1024
BATCH = 8
SEQ = 2048
DEPTH = 2

GRID_W = 64
CTX_LEN = 256
EPS = 1e-6
N_MOD = 6
N_BRANCH = 3
SSM_WIDTH = D_MODEL // 2
SSM_GROUP = 16
SSM_GROUPS = SSM_WIDTH // SSM_GROUP
SSM_STATE = 64
DT_MIN = 1e-3
DT_MAX = 1e-1
ATT_HEADS = 8
ATT_KV_HEADS = 2
ATT_GROUPS = ATT_HEADS // ATT_KV_HEADS
ATT_HEAD_DIM = 64
ATT_WIDTH = ATT_HEADS * ATT_HEAD_DIM
KV_WIDTH = ATT_KV_HEADS * ATT_HEAD_DIM
ROPE_FREQS = ATT_HEAD_DIM // 4
ROPE_BASE = 10000.0
Q_BLOCK = 128
ML_HEADS = 4
ML_HEAD_DIM = 128
ML_WIDTH = ML_HEADS * ML_HEAD_DIM
ML_GATES = 2 * 2 * ML_HEADS
ML_CHUNK = 128
PEER_HEADS = 8
PEER_KEYS = 128
PEER_EXPERTS = PEER_KEYS * PEER_KEYS
PEER_QDIM = 256
PEER_TOPK = 16
PEER_TOKEN_BLOCK = 128
IN_SPLITS = (SSM_WIDTH, ATT_WIDTH, KV_WIDTH, KV_WIDTH, ML_WIDTH, ML_WIDTH, ML_WIDTH, ML_WIDTH, ML_GATES, N_BRANCH * D_MODEL)
IN_WIDTH = SSM_WIDTH + ATT_WIDTH + 2 * KV_WIDTH + 4 * ML_WIDTH + ML_GATES + N_BRANCH * D_MODEL

kernel_name = 'hybrid_s5_gqa_mlstm_peer_dit_block'


def rmsnorm(x, g):
    xf = x.astype(jnp.float32)
    y = xf * lax.rsqrt(jnp.mean(xf * xf, axis=-1, keepdims=True) + EPS)
    return (y * g.astype(jnp.float32)).astype(x.dtype)


def flip_segments(z, n_ctx):
    zc, zl = jnp.split(z, [n_ctx], axis=1)
    return jnp.concatenate([jnp.flip(zc, axis=1), jnp.flip(zl, axis=1)], axis=1)


def axial_rope_tables(seq_len):
    rows = seq_len // GRID_W
    row = jnp.repeat(jnp.arange(rows, dtype=jnp.float32), GRID_W)
    col = jnp.tile(jnp.arange(GRID_W, dtype=jnp.float32), rows)
    inv = ROPE_BASE ** (-jnp.arange(ROPE_FREQS, dtype=jnp.float32) / ROPE_FREQS)
    ang = jnp.stack([row[:, None] * inv, col[:, None] * inv], axis=1)
    return jnp.cos(ang), jnp.sin(ang)


def apply_axial_rope(x, cos, sin):
    n_head_axes = x.ndim - 3
    cs_shape = (cos.shape[0],) + (1,) * n_head_axes + (2, ROPE_FREQS)
    c = cos.reshape(cs_shape).astype(x.dtype)
    s = sin.reshape(cs_shape).astype(x.dtype)
    xr = x.reshape(x.shape[:-1] + (2, 2, ROPE_FREQS))
    x1 = xr[..., 0, :]
    x2 = xr[..., 1, :]
    return jnp.stack([x1 * c - x2 * s, x1 * s + x2 * c], axis=-2).reshape(x.shape)


def complex_affine_combine(left, right):
    al_re, al_im, bl_re, bl_im = left
    ar_re, ar_im, br_re, br_im = right
    return (ar_re * al_re - ar_im * al_im,
            ar_re * al_im + ar_im * al_re,
            ar_re * bl_re - ar_im * bl_im + br_re,
            ar_re * bl_im + ar_im * bl_re + br_im)


def s5_scan(ug, lam_re, lam_im, log_step, b_re, b_im):
    f32 = jnp.float32
    lam_re = lam_re.astype(f32)
    lam_im = lam_im.astype(f32)
    b_re = b_re.astype(f32)
    b_im = b_im.astype(f32)
    step = jnp.exp(log_step.astype(f32))[:, None]
    mag = jnp.exp(lam_re * step)
    a_re = mag * jnp.cos(lam_im * step)
    a_im = mag * jnp.sin(lam_im * step)
    den = lam_re * lam_re + lam_im * lam_im
    z_re = ((a_re - 1.0) * lam_re + a_im * lam_im) / den
    z_im = (a_im * lam_re - (a_re - 1.0) * lam_im) / den
    bb_re = z_re[..., None] * b_re - z_im[..., None] * b_im
    bb_im = z_re[..., None] * b_im + z_im[..., None] * b_re
    u = ug.astype(f32)
    bu_re = jnp.einsum('bsgc,gnc->bsgn', u, bb_re)
    bu_im = jnp.einsum('bsgc,gnc->bsgn', u, bb_im)
    s_len = u.shape[1]
    a_re_s = jnp.broadcast_to(a_re, (1, s_len) + a_re.shape)
    a_im_s = jnp.broadcast_to(a_im, (1, s_len) + a_im.shape)
    _, _, s_re, s_im = lax.associative_scan(complex_affine_combine, (a_re_s, a_im_s, bu_re, bu_im), axis=1)
    return s_re, s_im


def s5_branch(u, n_ctx, lam_re, lam_im, log_step, b_re, b_im, c_re, c_im, d_skip, w_glu, latent_only):
    f32 = jnp.float32
    bsz, s_len, _ = u.shape
    ug = u.astype(f32).reshape(bsz, s_len, SSM_GROUPS, SSM_GROUP)
    y = d_skip.astype(f32) * u.astype(f32)
    for direction in range(2):
        seq = ug if direction == 0 else flip_segments(ug, n_ctx)
        s_re, s_im = s5_scan(seq, lam_re[direction], lam_im[direction], log_step[direction], b_re[direction], b_im[direction])
        yd = (jnp.einsum('bsgn,gcn->bsgc', s_re, c_re[direction].astype(f32))
              - jnp.einsum('bsgn,gcn->bsgc', s_im, c_im[direction].astype(f32))).reshape(bsz, s_len, SSM_WIDTH)
        if direction == 1:
            yd = flip_segments(yd, n_ctx)
        y = y + yd
    if latent_only:
        y = y[:, n_ctx:]
    y = jax.nn.gelu(y).astype(u.dtype)
    return y * jax.nn.sigmoid(y @ w_glu)


def softmax_attend(qb, kk, vv):
    s = jnp.einsum('bqhgd,bkhd->bhgqk', qb, kk).astype(jnp.float32) * (ATT_HEAD_DIM ** -0.5)
    p = jax.nn.softmax(s, axis=-1).astype(vv.dtype)
    return jnp.einsum('bhgqk,bkhd->bqhgd', p, vv)


def attention_branch(q, k, v, n_ctx, cos, sin, q_norm_g, k_norm_g, latent_only):
    bsz, s_len, _ = q.shape
    lat_len = s_len - n_ctx
    q = rmsnorm(q.reshape(bsz, s_len, ATT_KV_HEADS, ATT_GROUPS, ATT_HEAD_DIM), q_norm_g)
    k = rmsnorm(k.reshape(bsz, s_len, ATT_KV_HEADS, ATT_HEAD_DIM), k_norm_g)
    v = v.reshape(bsz, s_len, ATT_KV_HEADS, ATT_HEAD_DIM)
    q_lat = apply_axial_rope(q[:, n_ctx:], cos, sin)
    k_all = jnp.concatenate([k[:, :n_ctx], apply_axial_rope(k[:, n_ctx:], cos, sin)], axis=1)
    n_blk = lat_len // Q_BLOCK
    q_blocks = jnp.moveaxis(q_lat.reshape(bsz, n_blk, Q_BLOCK, ATT_KV_HEADS, ATT_GROUPS, ATT_HEAD_DIM), 1, 0)
    o_lat = lax.map(lambda qb: softmax_attend(qb, k_all, v), q_blocks)
    o_lat = jnp.moveaxis(o_lat, 0, 1).reshape(bsz, lat_len, ATT_WIDTH)
    if latent_only:
        return o_lat
    o_ctx = softmax_attend(q[:, :n_ctx], k[:, :n_ctx], v[:, :n_ctx]).reshape(bsz, n_ctx, ATT_WIDTH)
    return jnp.concatenate([o_ctx, o_lat], axis=1)


def mlstm_chunkwise(q, k, v, log_i, log_f):
    bsz, n_h, s_len, dk = q.shape
    dv = v.shape[-1]
    nc = s_len // ML_CHUNK

    def chunks(z):
        return jnp.moveaxis(z.reshape((bsz, n_h, nc, ML_CHUNK) + z.shape[3:]), 2, 0)

    tri = jnp.tril(jnp.ones((ML_CHUNK, ML_CHUNK), dtype=bool))

    def step(carry, inp):
        c_st, n_st, m_st = carry
        qt, kt, vt, it, ft = inp
        b = jnp.cumsum(ft, axis=-1)
        dmat = jnp.where(tri, b[..., :, None] - b[..., None, :] + it[..., None, :], -jnp.inf)
        inter = b + m_st[..., None]
        m_t = jnp.maximum(inter, jnp.max(dmat, axis=-1))
        w = jnp.exp(dmat - m_t[..., None])
        a_inter = jnp.exp(inter - m_t)
        qk = jnp.einsum('bhtd,bhsd->bhts', qt, kt) * w
        num = a_inter[..., None] * jnp.einsum('bhtd,bhvd->bhtv', qt, c_st) + jnp.einsum('bhts,bhsv->bhtv', qk, vt)
        den = a_inter * jnp.einsum('bhtd,bhd->bht', qt, n_st) + jnp.sum(qk, axis=-1)
        h_out = num / jnp.maximum(jnp.abs(den), jnp.exp(-m_t))[..., None]
        b_last = b[..., -1]
        d_last = b_last[..., None] - b + it
        m_new = jnp.maximum(b_last + m_st, jnp.max(d_last, axis=-1))
        w_last = jnp.exp(d_last - m_new[..., None])
        decay = jnp.exp(b_last + m_st - m_new)
        c_new = decay[..., None, None] * c_st + jnp.einsum('bhs,bhsv,bhsd->bhvd', w_last, vt, kt)
        n_new = decay[..., None] * n_st + jnp.einsum('bhs,bhsd->bhd', w_last, kt)
        return (c_new, n_new, m_new), h_out

    f32 = jnp.float32
    init = (jnp.zeros((bsz, n_h, dv, dk), f32), jnp.zeros((bsz, n_h, dk), f32), jnp.zeros((bsz, n_h), f32))
    _, hs = lax.scan(step, init, (chunks(q), chunks(k), chunks(v), chunks(log_i), chunks(log_f)))
    return jnp.moveaxis(hs, 0, 2).reshape(bsz, n_h, s_len, dv)


def mlstm_branch(q, k, v, o, gate_pre, n_ctx, gate_b, norm_g, latent_only):
    f32 = jnp.float32
    bsz, s_len, _ = q.shape
    gates = gate_pre.reshape(bsz, s_len, 2, 2, ML_HEADS).astype(f32) + gate_b.astype(f32)

    def to_heads(z):
        return z.reshape(bsz, s_len, ML_HEADS, ML_HEAD_DIM).transpose(0, 2, 1, 3).astype(f32)

    outs = []
    for direction in range(2):
        qd, kd, vd, gd = q, k, v, gates[:, :, direction]
        if direction == 1:
            qd, kd, vd, gd = flip_segments(qd, n_ctx), flip_segments(kd, n_ctx), flip_segments(vd, n_ctx), flip_segments(gd, n_ctx)
        log_i = gd[:, :, 0].transpose(0, 2, 1)
        log_f = jax.nn.log_sigmoid(gd[:, :, 1]).transpose(0, 2, 1)
        hd = mlstm_chunkwise(to_heads(qd), to_heads(kd) * (ML_HEAD_DIM ** -0.5), to_heads(vd), log_i, log_f)
        hd = hd.transpose(0, 2, 1, 3)
        if direction == 1:
            hd = flip_segments(hd, n_ctx)
        outs.append(hd)
    h_sum = outs[0] + outs[1]
    if latent_only:
        h_sum = h_sum[:, n_ctx:]
        o = o[:, n_ctx:]
    hn = rmsnorm(h_sum, norm_g.reshape(ML_HEADS, ML_HEAD_DIM))
    return (hn.reshape(hn.shape[0], hn.shape[1], ML_WIDTH) * jax.nn.sigmoid(o.astype(f32))).astype(q.dtype)


def hybrid_mixer(h, n_ctx, cos, sin, w_in, lam_re, lam_im, log_step, b_re, b_im, c_re, c_im, d_skip, w_glu,
                 q_norm_g, k_norm_g, ml_gate_b, ml_norm_g, w_br_ssm, w_br_attn, w_br_mlstm, w_out, latent_only):
    proj = h @ w_in
    offsets = np.cumsum(IN_SPLITS)[:-1].tolist()
    u_s, q_a, k_a, v_a, q_m, k_m, v_m, o_m, g_m, gate_logits = jnp.split(proj, offsets, axis=-1)
    y_s = s5_branch(u_s, n_ctx, lam_re, lam_im, log_step, b_re, b_im, c_re, c_im, d_skip, w_glu, latent_only)
    y_a = attention_branch(q_a, k_a, v_a, n_ctx, cos, sin, q_norm_g, k_norm_g, latent_only)
    y_m = mlstm_branch(q_m, k_m, v_m, o_m, g_m, n_ctx, ml_gate_b, ml_norm_g, latent_only)
    if latent_only:
        gate_logits = gate_logits[:, n_ctx:]
    gates = jax.nn.sigmoid(gate_logits.astype(jnp.float32)).astype(h.dtype)
    gates = gates.reshape(gate_logits.shape[:-1] + (N_BRANCH, D_MODEL))
    merged = (gates[..., 0, :] * (y_s @ w_br_ssm) + gates[..., 1, :] * (y_a @ w_br_attn)
              + gates[..., 2, :] * (y_m @ w_br_mlstm))
    return merged @ w_out


def peer_ffn(h, w_q, sub_k1, sub_k2, u_tab, v_tab):
    bsz, s_len, d = h.shape
    tok = h.reshape(bsz * s_len, d)
    half = PEER_QDIM // 2
    q = (tok @ w_q).reshape(-1, PEER_HEADS, 2, half)
    s1 = jnp.einsum('nhd,kd->nhk', q[:, :, 0], sub_k1).astype(jnp.float32)
    s2 = jnp.einsum('nhd,kd->nhk', q[:, :, 1], sub_k2).astype(jnp.float32)
    v1, i1 = lax.top_k(s1, PEER_TOPK)
    v2, i2 = lax.top_k(s2, PEER_TOPK)
    n_cand = PEER_TOPK * PEER_TOPK
    cand_s = (v1[..., :, None] + v2[..., None, :]).reshape(-1, PEER_HEADS, n_cand)
    cand_e = (i1[..., :, None] * PEER_KEYS + i2[..., None, :]).reshape(-1, PEER_HEADS, n_cand)
    top_s, top_j = lax.top_k(cand_s, PEER_TOPK)
    experts = jnp.take_along_axis(cand_e, top_j, axis=-1)
    gate = jax.nn.softmax(top_s, axis=-1)
    n_blk = tok.shape[0] // PEER_TOKEN_BLOCK

    def block(args):
        xb, eb, gb = args
        act = jax.nn.gelu(jnp.einsum('thkd,td->thk', u_tab[eb], xb).astype(jnp.float32))
        coef = (gb * act).astype(xb.dtype)
        return jnp.einsum('thk,thkd->td', coef, v_tab[eb])

    out = lax.map(block, (tok.reshape(n_blk, PEER_TOKEN_BLOCK, d),
                          experts.reshape(n_blk, PEER_TOKEN_BLOCK, PEER_HEADS, PEER_TOPK),
                          gate.reshape(n_blk, PEER_TOKEN_BLOCK, PEER_HEADS, PEER_TOPK)))
    return out.reshape(bsz, s_len, d)


def setup_inputs(seed: int = 0) -> dict:
    key = jax.random.key(seed)
    ks = list(jax.random.split(key, 40))
    f32 = jnp.float32

    def nrm(shape, scale):
        return jax.random.normal(ks.pop(), shape, f32) * scale

    x = nrm((BATCH, SEQ, D_MODEL), 1.0)
    c = nrm((BATCH, D_MODEL), 1.0)
    ctx = nrm((BATCH, CTX_LEN, D_MODEL), 1.0)
    c_ctx = nrm((D_MODEL,), 1.0)
    w_mod = nrm((DEPTH, D_MODEL, N_MOD * D_MODEL), 0.5 * D_MODEL ** -0.5)
    b_mod = nrm((DEPTH, N_MOD * D_MODEL), 0.01)
    norm1_g = 1.0 + nrm((DEPTH, D_MODEL), 0.02)
    norm2_g = 1.0 + nrm((DEPTH, D_MODEL), 0.02)
    w_in = nrm((DEPTH, D_MODEL, IN_WIDTH), D_MODEL ** -0.5)
    ssm_lam_re = -0.5 + nrm((DEPTH, 2, SSM_GROUPS, SSM_STATE), 0.01)
    ssm_lam_im = math.pi * jnp.arange(SSM_STATE, dtype=f32) + nrm((DEPTH, 2, SSM_GROUPS, SSM_STATE), 0.01)
    ssm_log_step = jax.random.uniform(ks.pop(), (DEPTH, 2, SSM_GROUPS), f32, math.log(DT_MIN), math.log(DT_MAX))
    ssm_b_re = nrm((DEPTH, 2, SSM_GROUPS, SSM_STATE, SSM_GROUP), (2 * SSM_GROUP) ** -0.5)
    ssm_b_im = nrm((DEPTH, 2, SSM_GROUPS, SSM_STATE, SSM_GROUP), (2 * SSM_GROUP) ** -0.5)
    ssm_c_re = nrm((DEPTH, 2, SSM_GROUPS, SSM_GROUP, SSM_STATE), SSM_STATE ** -0.5)
    ssm_c_im = nrm((DEPTH, 2, SSM_GROUPS, SSM_GROUP, SSM_STATE), SSM_STATE ** -0.5)
    ssm_d = nrm((DEPTH, SSM_WIDTH), 1.0)
    ssm_w_glu = nrm((DEPTH, SSM_WIDTH, SSM_WIDTH), SSM_WIDTH ** -0.5)
    attn_q_norm_g = 1.0 + nrm((DEPTH, ATT_HEAD_DIM), 0.02)
    attn_k_norm_g = 1.0 + nrm((DEPTH, ATT_HEAD_DIM), 0.02)
    gate_i = nrm((DEPTH, 2, ML_HEADS), 0.1)
    gate_f = jnp.linspace(3.0, 6.0, ML_HEADS, dtype=f32) + nrm((DEPTH, 2, ML_HEADS), 0.1)
    mlstm_gate_b = jnp.stack([gate_i, gate_f], axis=2)
    mlstm_norm_g = 1.0 + nrm((DEPTH, ML_WIDTH), 0.02)
    w_branch_ssm = nrm((DEPTH, SSM_WIDTH, D_MODEL), SSM_WIDTH ** -0.5)
    w_branch_attn = nrm((DEPTH, ATT_WIDTH, D_MODEL), ATT_WIDTH ** -0.5)
    w_branch_mlstm = nrm((DEPTH, ML_WIDTH, D_MODEL), ML_WIDTH ** -0.5)
    w_out = nrm((DEPTH, D_MODEL, D_MODEL), D_MODEL ** -0.5)
    peer_w_q = nrm((DEPTH, D_MODEL, PEER_HEADS * PEER_QDIM), D_MODEL ** -0.5)
    peer_sub_k1 = nrm((DEPTH, PEER_KEYS, PEER_QDIM // 2), (PEER_QDIM // 2) ** -0.5)
    peer_sub_k2 = nrm((DEPTH, PEER_KEYS, PEER_QDIM // 2), (PEER_QDIM // 2) ** -0.5)
    peer_u = nrm((DEPTH, PEER_EXPERTS, D_MODEL), D_MODEL ** -0.5)
    peer_v = nrm((DEPTH, PEER_EXPERTS, D_MODEL), 1.0)
    final_norm_g = 1.0 + nrm((D_MODEL,), 0.02)
    return {'x': x, 'c': c, 'ctx': ctx, 'c_ctx': c_ctx, 'w_mod': w_mod, 'b_mod': b_mod,
            'norm1_g': norm1_g, 'norm2_g': norm2_g, 'w_in': w_in,
            'ssm_lam_re': ssm_lam_re, 'ssm_lam_im': ssm_lam_im, 'ssm_log_step': ssm_log_step,
            'ssm_b_re': ssm_b_re, 'ssm_b_im': ssm_b_im, 'ssm_c_re': ssm_c_re, 'ssm_c_im': ssm_c_im,
            'ssm_d': ssm_d, 'ssm_w_glu': ssm_w_glu, 'attn_q_norm_g': attn_q_norm_g, 'attn_k_norm_g': attn_k_norm_g,
            'mlstm_gate_b': mlstm_gate_b, 'mlstm_norm_g': mlstm_norm_g,
            'w_branch_ssm': w_branch_ssm, 'w_branch_attn': w_branch_attn, 'w_branch_mlstm': w_branch_mlstm,
            'w_out': w_out, 'peer_w_q': peer_w_q, 'peer_sub_k1': peer_sub_k1, 'peer_sub_k2': peer_sub_k2,
            'peer_u': peer_u, 'peer_v': peer_v, 'final_norm_g': final_norm_g}


def reference(x, c, ctx, c_ctx, w_mod, b_mod, norm1_g, norm2_g, w_in,
              ssm_lam_re, ssm_lam_im, ssm_log_step, ssm_b_re, ssm_b_im, ssm_c_re, ssm_c_im,
              ssm_d, ssm_w_glu, attn_q_norm_g, attn_k_norm_g, mlstm_gate_b, mlstm_norm_g,
              w_branch_ssm, w_branch_attn, w_branch_mlstm, w_out,
              peer_w_q, peer_sub_k1, peer_sub_k2, peer_u, peer_v, final_norm_g):
    n_ctx = ctx.shape[1]
    seq_len = x.shape[1]
    cos, sin = axial_rope_tables(seq_len)
    stream = jnp.concatenate([ctx, x], axis=1)
    silu_c = jax.nn.silu(c)
    silu_ctx = jax.nn.silu(c_ctx)
    for layer in range(DEPTH):
        last = layer == DEPTH - 1
        mod_l = jnp.split(silu_c @ w_mod[layer] + b_mod[layer], N_MOD, axis=-1)
        mod_c = jnp.split(silu_ctx @ w_mod[layer] + b_mod[layer], N_MOD, axis=-1)
        sh1_l, sc1_l, g1_l, sh2_l, sc2_l, g2_l = [m[:, None, :] for m in mod_l]
        sh1_c, sc1_c, g1_c, sh2_c, sc2_c, g2_c = mod_c
        hn = rmsnorm(stream, norm1_g[layer])
        h = jnp.concatenate([hn[:, :n_ctx] * (1 + sc1_c) + sh1_c, hn[:, n_ctx:] * (1 + sc1_l) + sh1_l], axis=1)
        mix = hybrid_mixer(h, n_ctx, cos, sin, w_in[layer], ssm_lam_re[layer], ssm_lam_im[layer], ssm_log_step[layer],
                           ssm_b_re[layer], ssm_b_im[layer], ssm_c_re[layer], ssm_c_im[layer], ssm_d[layer], ssm_w_glu[layer],
                           attn_q_norm_g[layer], attn_k_norm_g[layer], mlstm_gate_b[layer], mlstm_norm_g[layer],
                           w_branch_ssm[layer], w_branch_attn[layer], w_branch_mlstm[layer], w_out[layer], last)
        if last:
            lat = stream[:, n_ctx:] + g1_l * mix
            h2 = rmsnorm(lat, norm2_g[layer]) * (1 + sc2_l) + sh2_l
            stream = lat + g2_l * peer_ffn(h2, peer_w_q[layer], peer_sub_k1[layer], peer_sub_k2[layer], peer_u[layer], peer_v[layer])
        else:
            stream = stream + jnp.concatenate([g1_c * mix[:, :n_ctx], g1_l * mix[:, n_ctx:]], axis=1)
            hn2 = rmsnorm(stream, norm2_g[layer])
            h2 = jnp.concatenate([hn2[:, :n_ctx] * (1 + sc2_c) + sh2_c, hn2[:, n_ctx:] * (1 + sc2_l) + sh2_l], axis=1)
            f = peer_ffn(h2, peer_w_q[layer], peer_sub_k1[layer], peer_sub_k2[layer], peer_u[layer], peer_v[layer])
            stream = stream + jnp.concatenate([g2_c * f[:, :n_ctx], g2_l * f[:, n_ctx:]], axis=1)
    return rmsnorm(stream, final_norm_g)
```

```cpp
#include <hip/hip_runtime.h>
#include <math.h>

#define DM 1024
#define NB 8
#define SEQ 2048
#define NCTX 256
#define S_ (SEQ + NCTX)
#define INW 6416
#define EPS 1e-6f
#define C_US 0
#define C_QA 512
#define C_KA 1024
#define C_VA 1152
#define C_QM 1280
#define C_KM 1792
#define C_VM 2304
#define C_OM 2816
#define C_GM 3328
#define C_GL 3344

__device__ __forceinline__ float gelu_tanh(float x) { const float c = 0.7978845608028654f; float u = c * (x + 0.044715f * x * x * x); return 0.5f * x * (1.f + tanhf(u)); }
__device__ __forceinline__ float sigm(float x) { return 1.f / (1.f + expf(-x)); }
__device__ __forceinline__ float wave_sum(float v) {
#pragma unroll
    for (int o = 32; o > 0; o >>= 1) v += __shfl_xor(v, o);
    return v;
}
__device__ __forceinline__ float block_sum256(float v, float* red) {
    red[threadIdx.x] = v; __syncthreads();
    for (int s = 128; s > 0; s >>= 1) { if ((int)threadIdx.x < s) red[threadIdx.x] += red[threadIdx.x + s]; __syncthreads(); }
    float r = red[0]; __syncthreads(); return r;
}
__device__ __forceinline__ float block_max256(float v, float* red) {
    red[threadIdx.x] = v; __syncthreads();
    for (int s = 128; s > 0; s >>= 1) { if ((int)threadIdx.x < s) red[threadIdx.x] = fmaxf(red[threadIdx.x], red[threadIdx.x + s]); __syncthreads(); }
    float r = red[0]; __syncthreads(); return r;
}

__global__ __launch_bounds__(256) void k_gemm(const float* __restrict__ A, int lda, const float* __restrict__ B, int ldb, float* __restrict__ C, int ldc, int M, int N, int K) {
    __shared__ float As[16][68];
    __shared__ float Bs[16][68];
    const int tid = threadIdx.x, tx = tid & 15, ty = tid >> 4;
    const int m0 = blockIdx.y * 64, n0 = blockIdx.x * 64;
    float acc[4][4];
#pragma unroll
    for (int i = 0; i < 4; ++i)
#pragma unroll
        for (int j = 0; j < 4; ++j) acc[i][j] = 0.f;
    const int ar = tid >> 2, ac = (tid & 3) * 4;
    const int br = tid >> 4, bc = (tid & 15) * 4;
    for (int k0 = 0; k0 < K; k0 += 16) {
        float4 av = make_float4(0.f, 0.f, 0.f, 0.f), bv = make_float4(0.f, 0.f, 0.f, 0.f);
        if (m0 + ar < M) av = *(const float4*)(A + (size_t)(m0 + ar) * lda + k0 + ac);
        if (n0 + bc < N) bv = *(const float4*)(B + (size_t)(k0 + br) * ldb + n0 + bc);
        As[ac + 0][ar] = av.x; As[ac + 1][ar] = av.y; As[ac + 2][ar] = av.z; As[ac + 3][ar] = av.w;
        Bs[br][bc + 0] = bv.x; Bs[br][bc + 1] = bv.y; Bs[br][bc + 2] = bv.z; Bs[br][bc + 3] = bv.w;
        __syncthreads();
#pragma unroll
        for (int kk = 0; kk < 16; ++kk) {
            float a[4], b[4];
#pragma unroll
            for (int i = 0; i < 4; ++i) a[i] = As[kk][ty * 4 + i];
#pragma unroll
            for (int j = 0; j < 4; ++j) b[j] = Bs[kk][tx * 4 + j];
#pragma unroll
            for (int i = 0; i < 4; ++i)
#pragma unroll
                for (int j = 0; j < 4; ++j) acc[i][j] += a[i] * b[j];
        }
        __syncthreads();
    }
#pragma unroll
    for (int i = 0; i < 4; ++i)
#pragma unroll
        for (int j = 0; j < 4; ++j) {
            int m = m0 + ty * 4 + i, n = n0 + tx * 4 + j;
            if (m < M && n < N) C[(size_t)m * ldc + n] = acc[i][j];
        }
}

__global__ void k_mod(const float* __restrict__ c, const float* __restrict__ cctx, const float* __restrict__ wmod, const float* __restrict__ bmod, float* __restrict__ mod) {
    int idx = blockIdx.x * blockDim.x + threadIdx.x;
    if (idx >= 2 * 9 * 6144) return;
    int j = idx % 6144, r = (idx / 6144) % 9, l = idx / (9 * 6144);
    const float* cv = r < 8 ? c + r * DM : cctx;
    const float* w = wmod + (size_t)l * DM * 6144 + j;
    float acc = 0.f;
    for (int k = 0; k < DM; ++k) { float x = cv[k]; acc += (x * sigm(x)) * w[(size_t)k * 6144]; }
    mod[idx] = acc + bmod[l * 6144 + j];
}

__global__ void k_init_stream(const float* __restrict__ x, const float* __restrict__ ctx, float* __restrict__ stream) {
    size_t idx = (size_t)blockIdx.x * blockDim.x + threadIdx.x;
    if (idx >= (size_t)NB * S_ * DM) return;
    int j = idx % DM; int t = (idx / DM) % S_; int b = idx / ((size_t)DM * S_);
    stream[idx] = t < NCTX ? ctx[((size_t)b * NCTX + t) * DM + j] : x[((size_t)b * SEQ + (t - NCTX)) * DM + j];
}

__global__ __launch_bounds__(256) void k_norm_mod(const float* __restrict__ xin, const float* __restrict__ g, const float* __restrict__ mod_lat, const float* __restrict__ mod_ctx, int sh_chunk, int sc_chunk, float* __restrict__ out) {
    __shared__ float red[256];
    int t = blockIdx.x; const float* modr = t < NCTX ? mod_ctx : mod_lat;
    const float* xr = xin + (size_t)t * DM;
    float v[4]; float ss = 0.f;
#pragma unroll
    for (int i = 0; i < 4; ++i) { v[i] = xr[threadIdx.x + 256 * i]; ss += v[i] * v[i]; }
    ss = block_sum256(ss, red);
    float r = rsqrtf(ss * (1.f / DM) + EPS);
#pragma unroll
    for (int i = 0; i < 4; ++i) { int j = threadIdx.x + 256 * i; out[(size_t)t * DM + j] = v[i] * r * g[j] * (1.f + modr[sc_chunk * DM + j]) + modr[sh_chunk * DM + j]; }
}

__global__ void k_resid(float* __restrict__ stream, const float* __restrict__ mix, const float* __restrict__ mod_lat, const float* __restrict__ mod_ctx, int g_chunk) {
    int idx = blockIdx.x * blockDim.x + threadIdx.x;
    if (idx >= S_ * DM) return;
    int j = idx % DM, t = idx / DM; const float* modr = t < NCTX ? mod_ctx : mod_lat;
    stream[idx] += modr[g_chunk * DM + j] * mix[idx];
}

__global__ __launch_bounds__(256) void k_final(const float* __restrict__ stream, const float* __restrict__ g, float* __restrict__ out) {
    __shared__ float red[256];
    int row = blockIdx.x; int b = row / SEQ, tt = row % SEQ;
    const float* xr = stream + ((size_t)b * S_ + NCTX + tt) * DM;
    float v[4]; float ss = 0.f;
#pragma unroll
    for (int i = 0; i < 4; ++i) { v[i] = xr[threadIdx.x + 256 * i]; ss += v[i] * v[i]; }
    ss = block_sum256(ss, red);
    float r = rsqrtf(ss * (1.f / DM) + EPS);
#pragma unroll
    for (int i = 0; i < 4; ++i) { int j = threadIdx.x + 256 * i; out[(size_t)row * DM + j] = v[i] * r * g[j]; }
}

__global__ void k_s5_coef(const float* __restrict__ lam_re, const float* __restrict__ lam_im, const float* __restrict__ log_step, const float* __restrict__ b_re, const float* __restrict__ b_im, float2* __restrict__ a, float2* __restrict__ bb) {
    int idx = blockIdx.x * blockDim.x + threadIdx.x;
    if (idx >= 2 * 32 * 64) return;
    int dg = idx / 64;
    float step = expf(log_step[dg]);
    float lr = lam_re[idx], li = lam_im[idx];
    float mag = expf(lr * step);
    float are = mag * cosf(li * step), aim = mag * sinf(li * step);
    float den = lr * lr + li * li;
    float zre = ((are - 1.f) * lr + aim * li) / den;
    float zim = (aim * lr - (are - 1.f) * li) / den;
    a[idx] = make_float2(are, aim);
    for (int c = 0; c < 16; ++c) {
        float br = b_re[idx * 16 + c], bi = b_im[idx * 16 + c];
        bb[idx * 16 + c] = make_float2(zre * br - zim * bi, zre * bi + zim * br);
    }
}
__device__ __forceinline__ int seqmap(int p, int dir) { return dir == 0 ? p : (p < NCTX ? (NCTX - 1 - p) : (S_ + NCTX - 1 - p)); }
__global__ __launch_bounds__(64) void k_s5_scan(const float* __restrict__ proj, const float2* __restrict__ a, const float2* __restrict__ bb, float2* __restrict__ St) {
    int dg = blockIdx.x; int n = threadIdx.x; int dir = dg / 32, g = dg % 32;
    int idx = dg * 64 + n;
    float2 av = a[idx];
    float2 bv[16];
#pragma unroll
    for (int c = 0; c < 16; ++c) bv[c] = bb[idx * 16 + c];
    float sre = 0.f, sim = 0.f;
    for (int p = 0; p < S_; ++p) {
        int tok = seqmap(p, dir);
        const float* u = proj + (size_t)tok * INW + C_US + g * 16;
        float bre = 0.f, bim = 0.f;
#pragma unroll
        for (int c = 0; c < 16; ++c) { float uu = u[c]; bre += bv[c].x * uu; bim += bv[c].y * uu; }
        float nre = av.x * sre - av.y * sim + bre;
        float nim = av.x * sim + av.y * sre + bim;
        sre = nre; sim = nim;
        St[((size_t)(dir * S_ + tok) * 32 + g) * 64 + n] = make_float2(sre, sim);
    }
}
__global__ void k_s5_out(const float* __restrict__ proj, const float2* __restrict__ St, const float* __restrict__ c_re, const float* __restrict__ c_im, const float* __restrict__ dskip, float* __restrict__ yg) {
    int idx = blockIdx.x * blockDim.x + threadIdx.x;
    if (idx >= S_ * 512) return;
    int ch = idx % 512, tok = idx / 512; int g = ch / 16, c = ch % 16;
    float y = dskip[ch] * proj[(size_t)tok * INW + C_US + ch];
    for (int dir = 0; dir < 2; ++dir) {
        const float2* s = St + ((size_t)(dir * S_ + tok) * 32 + g) * 64;
        const float* cr = c_re + ((size_t)(dir * 32 + g) * 16 + c) * 64;
        const float* ci = c_im + ((size_t)(dir * 32 + g) * 16 + c) * 64;
        float acc = 0.f;
        for (int n = 0; n < 64; ++n) { float2 sv = s[n]; acc += sv.x * cr[n] - sv.y * ci[n]; }
        y += acc;
    }
    yg[idx] = gelu_tanh(y);
}
__global__ void k_glu(const float* __restrict__ yg, const float* __restrict__ t, float* __restrict__ ys) {
    int idx = blockIdx.x * blockDim.x + threadIdx.x;
    if (idx >= S_ * 512) return;
    ys[idx] = yg[idx] * sigm(t[idx]);
}

__global__ __launch_bounds__(640) void k_qk_prep(const float* __restrict__ proj, const float* __restrict__ qg, const float* __restrict__ kg, float* __restrict__ qh, float* __restrict__ kh) {
    int t = blockIdx.x; int w = threadIdx.x >> 6, d = threadIdx.x & 63;
    float x, gw;
    if (w < 8) { x = proj[(size_t)t * INW + C_QA + w * 64 + d]; gw = qg[d]; }
    else { x = proj[(size_t)t * INW + C_KA + (w - 8) * 64 + d]; gw = kg[d]; }
    float ss = wave_sum(x * x);
    float xn = x * rsqrtf(ss * (1.f / 64.f) + EPS) * gw;
    float xp = __shfl_xor(xn, 16);
    float o = xn;
    if (t >= NCTX) {
        int pos = t - NCTX; int axis = d >> 5, half = (d >> 4) & 1, f = d & 15;
        float inv = powf(10000.f, -(float)f / 16.f);
        float ang = (float)(axis == 0 ? (pos / 64) : (pos % 64)) * inv;
        float cs = cosf(ang), sn = sinf(ang);
        o = half == 0 ? (xn * cs - xp * sn) : (xp * sn + xn * cs);
    }
    if (w < 8) qh[(size_t)t * 512 + w * 64 + d] = o; else kh[(size_t)t * 128 + (w - 8) * 64 + d] = o;
}
__global__ __launch_bounds__(256) void k_attn(const float* __restrict__ qh, const float* __restrict__ kh, const float* __restrict__ proj, float* __restrict__ ya) {
    __shared__ float qs[64]; __shared__ float p[S_]; __shared__ float red[256];
    int t = blockIdx.x, hq = blockIdx.y, kv = hq >> 2; int nk = t < NCTX ? NCTX : S_;
    int tid = threadIdx.x;
    if (tid < 64) qs[tid] = qh[(size_t)t * 512 + hq * 64 + tid];
    __syncthreads();
    float lmax = -INFINITY;
    for (int k = tid; k < nk; k += 256) {
        const float4* kr = (const float4*)(kh + (size_t)k * 128 + kv * 64);
        float s = 0.f;
#pragma unroll
        for (int i = 0; i < 16; ++i) { float4 kk = kr[i]; s += kk.x * qs[4 * i] + kk.y * qs[4 * i + 1] + kk.z * qs[4 * i + 2] + kk.w * qs[4 * i + 3]; }
        s *= 0.125f; p[k] = s; lmax = fmaxf(lmax, s);
    }
    float mx = block_max256(lmax, red);
    float lsum = 0.f;
    for (int k = tid; k < nk; k += 256) { float e = expf(p[k] - mx); p[k] = e; lsum += e; }
    float sum = block_sum256(lsum, red);
    int d = tid & 63, part = tid >> 6;
    float acc = 0.f;
    for (int k = part; k < nk; k += 4) acc += p[k] * proj[(size_t)k * INW + C_VA + kv * 64 + d];
    red[tid] = acc; __syncthreads();
    if (tid < 64) ya[(size_t)t * 512 + hq * 64 + tid] = (red[tid] + red[tid + 64] + red[tid + 128] + red[tid + 192]) / sum;
}

__device__ __forceinline__ float log_sigmoid(float x) { return x >= 0.f ? -log1pf(expf(-x)) : x - log1pf(expf(x)); }
__global__ __launch_bounds__(1024) void k_mlstm(const float* __restrict__ proj, const float* __restrict__ gate_b, float* __restrict__ hout) {
    __shared__ float qs[128], ks[128], vs[128]; __shared__ float gsh[2];
    int h = blockIdx.x, dir = blockIdx.y; int tid = threadIdx.x; int v = tid >> 3, d0 = (tid & 7) * 16;
    float C[16], nn[16];
#pragma unroll
    for (int j = 0; j < 16; ++j) { C[j] = 0.f; nn[j] = 0.f; }
    for (int p = 0; p < S_; ++p) {
        int tok = seqmap(p, dir);
        const float* pr = proj + (size_t)tok * INW;
        if (tid < 128) qs[tid] = pr[C_QM + h * 128 + tid];
        else if (tid < 256) ks[tid - 128] = pr[C_KM + h * 128 + tid - 128] * 0.08838834764831845f;
        else if (tid < 384) vs[tid - 256] = pr[C_VM + h * 128 + tid - 256];
        else if (tid == 384) gsh[0] = expf(pr[C_GM + dir * 8 + h] + gate_b[dir * 8 + h]);
        else if (tid == 385) gsh[1] = expf(log_sigmoid(pr[C_GM + dir * 8 + 4 + h] + gate_b[dir * 8 + 4 + h]));
        __syncthreads();
        float ii = gsh[0], fi = gsh[1], vv = vs[v];
        float num = 0.f, den = 0.f;
#pragma unroll
        for (int j = 0; j < 16; ++j) {
            float kk = ks[d0 + j], qq = qs[d0 + j];
            C[j] = fi * C[j] + ii * vv * kk; nn[j] = fi * nn[j] + ii * kk;
            num += C[j] * qq; den += nn[j] * qq;
        }
        num += __shfl_xor(num, 1); num += __shfl_xor(num, 2); num += __shfl_xor(num, 4);
        den += __shfl_xor(den, 1); den += __shfl_xor(den, 2); den += __shfl_xor(den, 4);
        if ((tid & 7) == 0) hout[((size_t)dir * S_ + tok) * 512 + h * 128 + v] = num / fmaxf(fabsf(den), 1.f);
        __syncthreads();
    }
}
__global__ __launch_bounds__(256) void k_mlstm_out(const float* __restrict__ hout, const float* __restrict__ proj, const float* __restrict__ ng, float* __restrict__ ym) {
    int t = blockIdx.x; int h = threadIdx.x >> 6, lane = threadIdx.x & 63;
    float a0 = hout[(size_t)t * 512 + h * 128 + lane] + hout[((size_t)S_ + t) * 512 + h * 128 + lane];
    float a1 = hout[(size_t)t * 512 + h * 128 + lane + 64] + hout[((size_t)S_ + t) * 512 + h * 128 + lane + 64];
    float ss = wave_sum(a0 * a0 + a1 * a1);
    float r = rsqrtf(ss * (1.f / 128.f) + EPS);
    int c0 = h * 128 + lane, c1 = c0 + 64;
    ym[(size_t)t * 512 + c0] = a0 * r * ng[c0] * sigm(proj[(size_t)t * INW + C_OM + c0]);
    ym[(size_t)t * 512 + c1] = a1 * r * ng[c1] * sigm(proj[(size_t)t * INW + C_OM + c1]);
}

__global__ void k_merge(const float* __restrict__ proj, const float* __restrict__ t0, const float* __restrict__ t1, const float* __restrict__ t2, float* __restrict__ merged) {
    int idx = blockIdx.x * blockDim.x + threadIdx.x;
    if (idx >= S_ * DM) return;
    int j = idx % DM, t = idx / DM; const float* gl = proj + (size_t)t * INW + C_GL;
    merged[idx] = sigm(gl[j]) * t0[idx] + sigm(gl[DM + j]) * t1[idx] + sigm(gl[2 * DM + j]) * t2[idx];
}

__global__ void k_peer_scores(const float* __restrict__ q, const float* __restrict__ k1, const float* __restrict__ k2, float* __restrict__ sc) {
    int idx = blockIdx.x * blockDim.x + threadIdx.x;
    if (idx >= S_ * 2048) return;
    int key = idx & 127, half = (idx >> 7) & 1, h = (idx >> 8) & 7, t = idx >> 11;
    const float* qq = q + (size_t)t * 2048 + h * 256 + half * 128;
    const float* kk = (half ? k2 : k1) + key * 128;
    float acc = 0.f;
    for (int d = 0; d < 128; ++d) acc += qq[d] * kk[d];
    sc[idx] = acc;
}
__device__ __forceinline__ void wave_argmax(float& m, int& mi) {
#pragma unroll
    for (int o = 32; o > 0; o >>= 1) {
        float om = __shfl_xor(m, o); int oi = __shfl_xor(mi, o);
        if (om > m || (om == m && oi < mi)) { m = om; mi = oi; }
    }
}
__global__ __launch_bounds__(256) void k_peer_select(const float* __restrict__ sc, int* __restrict__ eidx, float* __restrict__ gate) {
    __shared__ float sv[4][2][16]; __shared__ int si[4][2][16]; __shared__ float ts[4][16]; __shared__ int tj[4][16];
    int w = threadIdx.x >> 6, lane = threadIdx.x & 63; int pair = blockIdx.x * 4 + w;
    for (int half = 0; half < 2; ++half) {
        const float* s = sc + (size_t)pair * 256 + half * 128;
        float a = s[lane], b = s[lane + 64];
        for (int it = 0; it < 16; ++it) {
            float m = fmaxf(a, b); int mi = a >= b ? lane : lane + 64;
            wave_argmax(m, mi);
            if (lane == 0) { sv[w][half][it] = m; si[w][half][it] = mi; }
            if (mi == lane) a = -INFINITY;
            if (mi == lane + 64) b = -INFINITY;
        }
    }
    __syncthreads();
    float c[4];
#pragma unroll
    for (int r = 0; r < 4; ++r) c[r] = sv[w][0][lane >> 2] + sv[w][1][(lane & 3) * 4 + r];
    for (int it = 0; it < 16; ++it) {
        float m = c[0]; int mj = lane * 4;
#pragma unroll
        for (int r = 1; r < 4; ++r) if (c[r] > m) { m = c[r]; mj = lane * 4 + r; }
        wave_argmax(m, mj);
        if (lane == 0) { ts[w][it] = m; tj[w][it] = mj; }
#pragma unroll
        for (int r = 0; r < 4; ++r) if (lane * 4 + r == mj) c[r] = -INFINITY;
    }
    __syncthreads();
    if (lane < 16) {
        float s = ts[w][lane], mx = ts[w][0];
        float e = expf(s - mx);
        float sum = e;
        sum += __shfl_xor(sum, 1); sum += __shfl_xor(sum, 2); sum += __shfl_xor(sum, 4); sum += __shfl_xor(sum, 8);
        int j = tj[w][lane];
        eidx[(size_t)pair * 16 + lane] = si[w][0][j >> 4] * 128 + si[w][1][j & 15];
        gate[(size_t)pair * 16 + lane] = e / sum;
    }
}
__global__ __launch_bounds__(256) void k_peer_gather(const float* __restrict__ h2, const int* __restrict__ eidx, const float* __restrict__ gate, const float* __restrict__ U, const float* __restrict__ V, float* __restrict__ f) {
    __shared__ float xs[DM]; __shared__ float coef[128]; __shared__ int es[128];
    int t = blockIdx.x, tid = threadIdx.x, w = tid >> 6, lane = tid & 63;
#pragma unroll
    for (int i = 0; i < 4; ++i) xs[tid + 256 * i] = h2[(size_t)t * DM + tid + 256 * i];
    if (tid < 128) es[tid] = eidx[(size_t)t * 128 + tid];
    __syncthreads();
    for (int e = w; e < 128; e += 4) {
        const float* row = U + (size_t)es[e] * DM;
        float p = 0.f;
#pragma unroll
        for (int j = 0; j < 16; ++j) p += row[lane + 64 * j] * xs[lane + 64 * j];
        p = wave_sum(p);
        if (lane == 0) coef[e] = gate[(size_t)t * 128 + e] * gelu_tanh(p);
    }
    __syncthreads();
    float acc[4] = {0.f, 0.f, 0.f, 0.f};
    for (int e = 0; e < 128; ++e) {
        const float* row = V + (size_t)es[e] * DM; float cf = coef[e];
#pragma unroll
        for (int i = 0; i < 4; ++i) acc[i] += cf * row[tid + 256 * i];
    }
#pragma unroll
    for (int i = 0; i < 4; ++i) f[(size_t)t * DM + tid + 256 * i] = acc[i];
}

static void gemm(hipStream_t st, const float* A, int lda, const float* B, int ldb, float* C, int ldc, int M, int N, int K) {
    dim3 grid((N + 63) / 64, (M + 63) / 64);
    k_gemm<<<grid, 256, 0, st>>>(A, lda, B, ldb, C, ldc, M, N, K);
}

extern "C" void kernel_launch(void* const* d_in, const int* in_sizes, int n_in, void* d_out, int out_size, void* d_ws, size_t ws_size, hipStream_t stream) {
    const float* x = (const float*)d_in[0]; const float* c = (const float*)d_in[1]; const float* ctx = (const float*)d_in[2]; const float* cctx = (const float*)d_in[3];
    const float* w_mod = (const float*)d_in[4]; const float* b_mod = (const float*)d_in[5]; const float* norm1_g = (const float*)d_in[6]; const float* norm2_g = (const float*)d_in[7];
    const float* w_in = (const float*)d_in[8];
    const float* lam_re = (const float*)d_in[9]; const float* lam_im = (const float*)d_in[10]; const float* log_step = (const float*)d_in[11];
    const float* b_re = (const float*)d_in[12]; const float* b_im = (const float*)d_in[13]; const float* c_re = (const float*)d_in[14]; const float* c_im = (const float*)d_in[15];
    const float* ssm_d = (const float*)d_in[16]; const float* w_glu = (const float*)d_in[17]; const float* qng = (const float*)d_in[18]; const float* kng = (const float*)d_in[19];
    const float* gate_b = (const float*)d_in[20]; const float* ml_ng = (const float*)d_in[21];
    const float* w_bs = (const float*)d_in[22]; const float* w_ba = (const float*)d_in[23]; const float* w_bm = (const float*)d_in[24]; const float* w_out = (const float*)d_in[25];
    const float* w_q = (const float*)d_in[26]; const float* sk1 = (const float*)d_in[27]; const float* sk2 = (const float*)d_in[28];
    const float* pu = (const float*)d_in[29]; const float* pv = (const float*)d_in[30]; const float* fng = (const float*)d_in[31];
    float* out = (float*)d_out;

    float* ws = (float*)d_ws; size_t off = 0;
    auto alloc = [&](size_t n) { float* p = ws + off; off += (n + 63) / 64 * 64; return p; };
    float* strm = alloc((size_t)NB * S_ * DM);
    float* mod = alloc(2 * 9 * 6144);
    float2* s5a = (float2*)alloc(2 * 32 * 64 * 2);
    float2* s5bb = (float2*)alloc(2 * 32 * 64 * 16 * 2);
    float* hbuf = alloc((size_t)S_ * DM);
    float* proj = alloc((size_t)S_ * INW);
    float2* St = (float2*)alloc((size_t)2 * S_ * 32 * 64 * 2);
    float* yg = alloc((size_t)S_ * 512); float* t512 = alloc((size_t)S_ * 512); float* ys = alloc((size_t)S_ * 512);
    float* qh = alloc((size_t)S_ * 512); float* kh = alloc((size_t)S_ * 128); float* ya = alloc((size_t)S_ * 512);
    float* hout = alloc((size_t)2 * S_ * 512); float* ym = alloc((size_t)S_ * 512);
    float* t0 = alloc((size_t)S_ * DM); float* t1 = alloc((size_t)S_ * DM); float* t2 = alloc((size_t)S_ * DM);
    float* merged = alloc((size_t)S_ * DM); float* mix = alloc((size_t)S_ * DM);
    float* qb = alloc((size_t)S_ * 2048); float* sc = alloc((size_t)S_ * 2048);
    int* eidx = (int*)alloc((size_t)S_ * 128); float* gate = alloc((size_t)S_ * 128);
    float* fbuf = alloc((size_t)S_ * DM);

    k_mod<<<(2 * 9 * 6144 + 255) / 256, 256, 0, stream>>>(c, cctx, w_mod, b_mod, mod);
    k_init_stream<<<(unsigned)(((size_t)NB * S_ * DM + 255) / 256), 256, 0, stream>>>(x, ctx, strm);

    for (int l = 0; l < 2; ++l) {
        k_s5_coef<<<(2 * 32 * 64 + 255) / 256, 256, 0, stream>>>(lam_re + l * 4096, lam_im + l * 4096, log_step + l * 64, b_re + l * 65536, b_im + l * 65536, s5a, s5bb);
        const float* modc = mod + (l * 9 + 8) * 6144;
        for (int b = 0; b < NB; ++b) {
            float* sb = strm + (size_t)b * S_ * DM;
            const float* modl = mod + (l * 9 + b) * 6144;
            k_norm_mod<<<S_, 256, 0, stream>>>(sb, norm1_g + l * DM, modl, modc, 0, 1, hbuf);
            gemm(stream, hbuf, DM, w_in + (size_t)l * DM * INW, INW, proj, INW, S_, INW, DM);
            k_s5_scan<<<64, 64, 0, stream>>>(proj, s5a, s5bb, St);
            k_s5_out<<<(S_ * 512 + 255) / 256, 256, 0, stream>>>(proj, St, c_re + l * 65536, c_im + l * 65536, ssm_d + l * 512, yg);
            gemm(stream, yg, 512, w_glu + (size_t)l * 512 * 512, 512, t512, 512, S_, 512, 512);
            k_glu<<<(S_ * 512 + 255) / 256, 256, 0, stream>>>(yg, t512, ys);
            k_qk_prep<<<S_, 640, 0, stream>>>(proj, qng + l * 64, kng + l * 64, qh, kh);
            k_attn<<<dim3(S_, 8), 256, 0, stream>>>(qh, kh, proj, ya);
            k_mlstm<<<dim3(4, 2), 1024, 0, stream>>>(proj, gate_b + l * 16, hout);
            k_mlstm_out<<<S_, 256, 0, stream>>>(hout, proj, ml_ng + l * 512, ym);
            gemm(stream, ys, 512, w_bs + (size_t)l * 512 * DM, DM, t0, DM, S_, DM, 512);
            gemm(stream, ya, 512, w_ba + (size_t)l * 512 * DM, DM, t1, DM, S_, DM, 512);
            gemm(stream, ym, 512, w_bm + (size_t)l * 512 * DM, DM, t2, DM, S_, DM, 512);
            k_merge<<<(S_ * DM + 255) / 256, 256, 0, stream>>>(proj, t0, t1, t2, merged);
            gemm(stream, merged, DM, w_out + (size_t)l * DM * DM, DM, mix, DM, S_, DM, DM);
            k_resid<<<(S_ * DM + 255) / 256, 256, 0, stream>>>(sb, mix, modl, modc, 2);
            k_norm_mod<<<S_, 256, 0, stream>>>(sb, norm2_g + l * DM, modl, modc, 3, 4, hbuf);
            gemm(stream, hbuf, DM, w_q + (size_t)l * DM * 2048, 2048, qb, 2048, S_, 2048, DM);
            k_peer_scores<<<(S_ * 2048 + 255) / 256, 256, 0, stream>>>(qb, sk1 + l * 16384, sk2 + l * 16384, sc);
            k_peer_select<<<S_ * 8 / 4, 256, 0, stream>>>(sc, eidx, gate);
            k_peer_gather<<<S_, 256, 0, stream>>>(hbuf, eidx, gate, pu + (size_t)l * 16384 * DM, pv + (size_t)l * 16384 * DM, fbuf);
            k_resid<<<(S_ * DM + 255) / 256, 256, 0, stream>>>(sb, fbuf, modl, modc, 5);
        }
    }
    k_final<<<NB * SEQ, 256, 0, stream>>>(strm, fng, out);
}
```

```cpp
#ifndef PEER_FP6
#define PEER_FP4 1
#endif
#include <hip/hip_runtime.h>
#include <hip/hip_bf16.h>
#include <cstdio>
#include <cstdint>
#include <math.h>

constexpr int DM_ = 1024, NB = 8, SEQ = 2048, NCTX = 256, SB = SEQ + NCTX, MROWS = NB * SB;
constexpr int INW = 6416, PW = 6656;
#define ATT_PITCH_ELEMS 6656
constexpr int PC_US = 0, PC_QA = 512, PC_KA = 1024, PC_VA = 1152, PC_QM = 1280, PC_KM = 1792, PC_VM = 2304, PC_OM = 2816, PC_GL = 3328, PC_GM = 6400;
constexpr float EPS_ = 1e-6f;

namespace pg8 {
#define PG8_LAS __attribute__((address_space(3)))
typedef unsigned short bf16_t;
typedef short bf16x8 __attribute__((ext_vector_type(8)));
typedef float f32x4 __attribute__((ext_vector_type(4)));
typedef unsigned u32x4 __attribute__((ext_vector_type(4)));
constexpr int BM = 256, BK = 64, HALF = 128, HTB = HALF * BK * 2  , STAGE_BYTES = 8 * HTB, NXCD = 8, WGM = 8;

__host__ __device__ __forceinline__ int lds_byte(int r, int c) { const int st = (r >> 4) * 2 + (c >> 5), rr = r & 15, cc = c & 31, ob = rr * 64 + cc * 2; return st * 1024 + (ob ^ (((ob >> 9) & 1) << 5)); }
__host__ __device__ __forceinline__ void stage_rc(int b, int& R, int& C) { const int st = b / 1024, sb = b % 1024, swz = sb ^ (((sb >> 9) & 1) << 5); R = (st >> 1) * 16 + swz / 64; C = (st & 1) * 32 + (swz % 64) / 2; }
__host__ __device__ __forceinline__ int perm32(int rho) { const int n = rho >> 4, i = rho & 15; return 8 * (i >> 2) + 4 * n + (i & 3); }

struct Unit { int pm, pn; };
struct Gemm { const bf16_t* A; const bf16_t* Bt; int M, N, K, lda, ldb; };

struct StaticOrder {
    int nM, nN, nwg, G, c;
    __host__ __device__ void init(int M, int N, int G_, int c_) { nM = M / BM; nN = N / BM; nwg = nM * nN; G = G_; c = c_; }
    __host__ __device__ bool next(int i, Unit& u) const {
        const long L = (long)i * G + c; if (L >= nwg) return false;
        int wgid = (int)L; { const int q = nwg / NXCD, r = nwg % NXCD, xcd = wgid % NXCD, off = wgid / NXCD; wgid = (xcd < r ? xcd * (q + 1) : r * (q + 1) + (xcd - r) * q) + off; }
        const int nig = WGM * nN, gid = wgid / nig, fm = gid * WGM, gsz = (nM - fm) < WGM ? (nM - fm) : WGM;
        u.pm = fm + ((wgid % nig) % gsz); u.pn = (wgid % nig) / gsz; return true;
    }
    __device__ __forceinline__ void a_ready(const Unit&) const {}
    __device__ __forceinline__ void done(const Unit&) const {}
};

__device__ __forceinline__ unsigned cvt_pk_bf16(float lo, float hi) { unsigned r; asm volatile("v_cvt_pk_bf16_f32 %0, %1, %2" : "=v"(r) : "v"(lo), "v"(hi)); return r; }
typedef float f32x2 __attribute__((ext_vector_type(2)));
__device__ __forceinline__ f32x2 gelu_pk(f32x2 v) {
    const f32x2 av = __builtin_elementwise_abs(v), d = av * 0.2316418882f + 1.0f;
    f32x2 t; t.x = __builtin_amdgcn_rcpf(d.x); t.y = __builtin_amdgcn_rcpf(d.y);
    f32x2 q = t * 0.5307027145f + (-0.7265760135f); q = q * t + 0.7107068705f; q = q * t + (-0.142248368f); q = q * t + 0.127414796f; q = q * t;
    const f32x2 s = (v * v) * (-0.72134752044f);
    f32x2 e; e.x = __builtin_amdgcn_exp2f(s.x); e.y = __builtin_amdgcn_exp2f(s.y);
    const f32x2 m = v * (q * e), r = v - m;
    f32x2 o; o.x = v.x < 0.f ? m.x : r.x; o.y = v.y < 0.f ? m.y : r.y; return o;
}

template <int ACT  > struct EpiBf16 {
    static constexpr bool PERM = true, AFTER_DRAIN = false; static_assert(ACT == 0 || ACT == 1, "EpiBf16: ACT is 0 (none) or 1 (gelu_pk)");
    bf16_t* O; int ldc; const float* bias; int split_cols; size_t split_stride; float scale0;
    __device__ __forceinline__ void operator()(const f32x4 (&acc)[2][2][4][2], const Unit& u, int wr, int wc, int fr, int fq) const {
        const int row0 = u.pm * BM + wr * 64 + fr; int colt = u.pn * BM; bf16_t* base = O;
        float sc = 1.f; if (split_cols) { const int t = colt / split_cols; base += (size_t)t * split_stride; colt -= t * split_cols; if (t == 0) sc = scale0; }
        const int col0 = colt + wc * 32 + 8 * fq, bcol0 = u.pn * BM + wc * 32 + 8 * fq;
        f32x4 bv[2][2];
#pragma unroll
        for (int bj = 0; bj < 2; ++bj)
#pragma unroll
            for (int n = 0; n < 2; ++n) bv[bj][n] = bias ? *(const f32x4*)(bias + bcol0 + bj * HALF + 4 * n) : (f32x4){0.f, 0.f, 0.f, 0.f};
#pragma unroll
        for (int ai = 0; ai < 2; ++ai)
#pragma unroll
            for (int m = 0; m < 4; ++m) { bf16_t* rowp = base + (size_t)(row0 + ai * HALF + m * 16) * ldc + col0;
#pragma unroll
                for (int bj = 0; bj < 2; ++bj) { f32x4 v0 = acc[ai][bj][m][0] + bv[bj][0], v1 = acc[ai][bj][m][1] + bv[bj][1];
                    if (ACT == 1) { f32x2 a = gelu_pk((f32x2){v0[0], v0[1]}), b = gelu_pk((f32x2){v0[2], v0[3]}), c = gelu_pk((f32x2){v1[0], v1[1]}), d = gelu_pk((f32x2){v1[2], v1[3]});
                        v0 = (f32x4){a.x, a.y, b.x, b.y}; v1 = (f32x4){c.x, c.y, d.x, d.y}; }
                    v0 = v0 * sc; v1 = v1 * sc; u32x4 w; w.x = cvt_pk_bf16(v0[0], v0[1]); w.y = cvt_pk_bf16(v0[2], v0[3]); w.z = cvt_pk_bf16(v1[0], v1[1]); w.w = cvt_pk_bf16(v1[2], v1[3]);
                    *(u32x4*)(rowp + bj * HALF) = w; } }
    }
};
template <class Epi, class Sched, bool ALIGN_EPI = false, bool SP2 = false>
__device__ __forceinline__ void gemm_phase(PG8_LAS unsigned char* lds, const Gemm g, const Sched& S, const Epi& E) {
    int tid_l = threadIdx.x; asm volatile("" : "+v"(tid_l)); const int tid = tid_l, wid = __builtin_amdgcn_readfirstlane(tid >> 6), lane = tid & 63, wr = wid >> 2, wc = wid & 3, fr = lane & 15, fq = lane >> 4;
    const int K = g.K, nt = K / BK;
    unsigned voffA[2], voffB[2];
#pragma unroll
    for (int i = 0; i < 2; ++i) { int R, C; stage_rc(tid * 16 + i * 8192, R, C); const int Rb = Epi::PERM ? ((R & ~31) + perm32(R & 31)) : R;
        voffA[i] = (unsigned)(R * g.lda + C) * 2u; voffB[i] = (unsigned)(Rb * g.ldb + C) * 2u; }
    const size_t kstep = (size_t)(BK * 2);
    const size_t hstepA = (size_t)HALF * g.lda * 2, hstepB = (size_t)HALF * g.ldb * 2;
    const size_t tstepA = 2 * hstepA, tstepB = 2 * hstepB;
    const unsigned ldsw = (unsigned)wid * 1024u;
    const int aoff = lds_byte(wr * 64 + fr, fq * 8), boff = lds_byte(wc * 32 + fr, fq * 8);
#define PG8_SA(b, h) (((b) * 2 + (h)) * HTB)
#define PG8_SB(b, h) ((4 + (b) * 2 + (h)) * HTB)
#define PG8_STAGE(bufoff, gbase, voff) do { _Pragma("unroll") for (int _i = 0; _i < 2; ++_i) \
        __builtin_amdgcn_global_load_lds((const unsigned*)((const char*)(gbase) + (voff)[_i]), (PG8_LAS unsigned*)(lds + (bufoff) + ldsw + _i * 8192), 16, 0, 0); } while (0)
#define PG8_LDA(dst, b, h) do { _Pragma("unroll") for (int m = 0; m < 4; ++m) _Pragma("unroll") for (int k = 0; k < 2; ++k) dst[m][k] = *(const PG8_LAS bf16x8*)(lds + PG8_SA(b, h) + aoff + m * 2048 + k * 1024); } while (0)
#define PG8_LDB(dst, b, h) do { _Pragma("unroll") for (int n = 0; n < 2; ++n) _Pragma("unroll") for (int k = 0; k < 2; ++k) dst[n][k] = *(const PG8_LAS bf16x8*)(lds + PG8_SB(b, h) + boff + n * 2048 + k * 1024); } while (0)
#define PG8_MMA(ai, bj, At, Bt) do { __builtin_amdgcn_s_setprio(1); _Pragma("unroll") for (int m = 0; m < 4; ++m) _Pragma("unroll") for (int n = 0; n < 2; ++n) _Pragma("unroll") for (int k = 0; k < 2; ++k) \
        acc[ai][bj][m][n] = __builtin_amdgcn_mfma_f32_16x16x32_bf16(Bt[n][k], At[m][k], acc[ai][bj][m][n], 0, 0, 0); __builtin_amdgcn_s_setprio(0); } while (0)
#define PG8_WAIT_V(n) asm volatile("s_waitcnt vmcnt(" #n ")" ::: "memory")
#define PG8_WAIT_L(n) asm volatile("s_waitcnt lgkmcnt(" #n ")" ::: "memory")
#define PG8_BAR __builtin_amdgcn_s_barrier()
#define PG8_SCHED __builtin_amdgcn_sched_barrier(0)
    Unit cur, nxt; int ui = 0;
    if (!S.next(0, cur)) return;
    f32x4 acc[2][2][4][2];
#pragma unroll
    for (int a = 0; a < 2; ++a)
#pragma unroll
        for (int b = 0; b < 2; ++b)
#pragma unroll
            for (int m = 0; m < 4; ++m)
#pragma unroll
                for (int n = 0; n < 2; ++n) acc[a][b][m][n] = (f32x4){0.f, 0.f, 0.f, 0.f};
    bf16x8 At[4][2], B0[2][2], B1[2][2];
    const char* cA = (const char*)g.A + (size_t)cur.pm * tstepA; const char* cB = (const char*)g.Bt + (size_t)cur.pn * tstepB;
    S.a_ready(cur);
    if constexpr (SP2) {
        PG8_STAGE(PG8_SB(0, 0), cB, voffB); PG8_STAGE(PG8_SB(0, 1), cB + hstepB, voffB); PG8_STAGE(PG8_SA(0, 0), cA, voffA); PG8_STAGE(PG8_SA(0, 1), cA + hstepA, voffA);
        if (wr == 1) PG8_BAR;
        PG8_WAIT_V(2); PG8_BAR;
        PG8_STAGE(PG8_SB(1, 0), cB + kstep, voffB); PG8_STAGE(PG8_SA(1, 0), cA + kstep, voffA); PG8_STAGE(PG8_SB(1, 1), cB + hstepB + kstep, voffB);
        PG8_WAIT_V(6); PG8_BAR;
    } else {
        PG8_STAGE(PG8_SB(0, 0), cB, voffB); PG8_STAGE(PG8_SA(0, 0), cA, voffA); PG8_STAGE(PG8_SB(0, 1), cB + hstepB, voffB); PG8_STAGE(PG8_SA(0, 1), cA + hstepA, voffA);
        if (wr == 1) PG8_BAR;
        PG8_WAIT_V(4); PG8_BAR;
        PG8_STAGE(PG8_SB(1, 0), cB + kstep, voffB); PG8_STAGE(PG8_SA(1, 0), cA + kstep, voffA); PG8_STAGE(PG8_SB(1, 1), cB + hstepB + kstep, voffB);
        PG8_WAIT_V(6); PG8_BAR;
    }
    for (;;) {
        const bool has_next = S.next(ui + 1, nxt);
        const char* nA = has_next ? (const char*)g.A + (size_t)nxt.pm * tstepA : cA; const char* nB = has_next ? (const char*)g.Bt + (size_t)nxt.pn * tstepB : cB;
        for (int t = 0; t < nt; t += 2) {
            const bool last = (t == nt - 2);
            const char* a1 = cA + (size_t)(t + 1) * kstep;
            const char* a2 = last ? nA : cA + (size_t)(t + 2) * kstep; const char* b2 = last ? nB : cB + (size_t)(t + 2) * kstep;
            const char* a3 = a2 + kstep; const char* b3 = b2 + kstep;
            if (last && has_next) S.a_ready(nxt);
            if constexpr (SP2) {
            PG8_LDB(B0, 0, 0); PG8_LDB(B1, 0, 1); PG8_SCHED; PG8_LDA(At, 0, 0); PG8_STAGE(PG8_SA(1, 1), a1 + hstepA, voffA);
            PG8_WAIT_V(8); PG8_WAIT_L(0); PG8_BAR; PG8_MMA(0, 0, At, B0); PG8_MMA(0, 1, At, B1); PG8_BAR; PG8_SCHED;
            PG8_LDA(At, 0, 1); PG8_STAGE(PG8_SB(0, 0), b2, voffB); PG8_STAGE(PG8_SB(0, 1), b2 + hstepB, voffB); PG8_STAGE(PG8_SA(0, 0), a2, voffA);
            PG8_WAIT_V(8); PG8_WAIT_L(0); PG8_BAR; PG8_MMA(1, 0, At, B0); PG8_MMA(1, 1, At, B1); PG8_BAR; PG8_SCHED;
            PG8_LDB(B0, 1, 0); PG8_LDB(B1, 1, 1); PG8_SCHED; PG8_LDA(At, 1, 0); PG8_STAGE(PG8_SA(0, 1), a2 + hstepA, voffA);
            PG8_WAIT_V(8); PG8_WAIT_L(0); PG8_BAR; PG8_MMA(0, 0, At, B0); PG8_MMA(0, 1, At, B1); PG8_BAR; PG8_SCHED;
            PG8_LDA(At, 1, 1); PG8_STAGE(PG8_SB(1, 0), b3, voffB); PG8_STAGE(PG8_SB(1, 1), b3 + hstepB, voffB); PG8_STAGE(PG8_SA(1, 0), a3, voffA);
            PG8_WAIT_V(8); PG8_WAIT_L(0); PG8_BAR; PG8_MMA(1, 0, At, B0); PG8_MMA(1, 1, At, B1); PG8_BAR; PG8_SCHED;
            } else {
            PG8_LDB(B0, 0, 0); PG8_SCHED; PG8_LDA(At, 0, 0); PG8_STAGE(PG8_SA(1, 1), a1 + hstepA, voffA);
            PG8_WAIT_L(8); PG8_BAR; PG8_WAIT_L(0); PG8_MMA(0, 0, At, B0); PG8_BAR; PG8_SCHED;
            PG8_LDB(B1, 0, 1); PG8_STAGE(PG8_SB(0, 0), b2, voffB);
            PG8_BAR; PG8_WAIT_L(0); PG8_MMA(0, 1, At, B1); PG8_BAR;
            PG8_LDA(At, 0, 1); PG8_STAGE(PG8_SA(0, 0), a2, voffA);
            PG8_BAR; PG8_WAIT_L(0); PG8_MMA(1, 0, At, B0); PG8_BAR; PG8_SCHED;
            PG8_STAGE(PG8_SB(0, 1), b2 + hstepB, voffB);
            PG8_WAIT_V(6); PG8_BAR; PG8_MMA(1, 1, At, B1); PG8_BAR;
            PG8_LDB(B0, 1, 0); PG8_SCHED; PG8_LDA(At, 1, 0); PG8_STAGE(PG8_SA(0, 1), a2 + hstepA, voffA);
            PG8_WAIT_L(8); PG8_BAR; PG8_WAIT_L(0); PG8_MMA(0, 0, At, B0); PG8_BAR; PG8_SCHED;
            PG8_LDB(B1, 1, 1); PG8_STAGE(PG8_SB(1, 0), b3, voffB);
            PG8_BAR; PG8_WAIT_L(0); PG8_MMA(0, 1, At, B1); PG8_BAR;
            PG8_LDA(At, 1, 1); PG8_STAGE(PG8_SA(1, 0), a3, voffA);
            PG8_BAR; PG8_WAIT_L(0); PG8_MMA(1, 0, At, B0); PG8_BAR; PG8_SCHED;
            PG8_STAGE(PG8_SB(1, 1), b3 + hstepB, voffB);
            PG8_WAIT_V(6); PG8_BAR; PG8_MMA(1, 1, At, B1); PG8_BAR;
            }
        }
        if constexpr (ALIGN_EPI) { if (wr == 0) PG8_BAR; }
        if constexpr (!Epi::AFTER_DRAIN) { E(acc, cur, wr, wc, fr, fq); S.done(cur); }
        if (!has_next) break;
#pragma unroll
        for (int a = 0; a < 2; ++a)
#pragma unroll
            for (int b = 0; b < 2; ++b)
#pragma unroll
                for (int m = 0; m < 4; ++m)
#pragma unroll
                    for (int n = 0; n < 2; ++n) acc[a][b][m][n] = (f32x4){0.f, 0.f, 0.f, 0.f};
        cur = nxt; cA = nA; cB = nB; ++ui;
        if constexpr (ALIGN_EPI) { if (wr == 1) PG8_BAR; }
    }
    PG8_WAIT_V(0);
    if constexpr (!ALIGN_EPI) { if (wr == 0) PG8_BAR; }
    PG8_BAR;
    if constexpr (Epi::AFTER_DRAIN) { E.fused(acc, cur, wr, wc, fr, fq, lds, wid, lane); S.done(cur); }
#undef PG8_SA
#undef PG8_SB
#undef PG8_STAGE
#undef PG8_LDA
#undef PG8_LDB
#undef PG8_MMA
#undef PG8_WAIT_V
#undef PG8_WAIT_L
#undef PG8_BAR
#undef PG8_SCHED
}
}
#include <hip/hip_bf16.h>
#include <cmath>
namespace attn_body {
using bf16=__hip_bfloat16;
using bf16x8=__attribute__((ext_vector_type(8)))short;
using s16x4=__attribute__((ext_vector_type(4)))short;
using f32x16=__attribute__((ext_vector_type(16)))float;
using u32x4=__attribute__((ext_vector_type(4)))unsigned;
constexpr int D=64,DM=ATT_PITCH_ELEMS;
constexpr int NW=8,QBLK=32,QB=QBLK*NW,KVBLK=64;
constexpr int ATTN_UNIT_ROWS=QB;
__device__ __forceinline__ int crow(int r,int hi){return (r&3)+8*(r>>2)+4*hi;}
#define SBAR() __builtin_amdgcn_sched_barrier(0)
__device__ __forceinline__ void cmask(f32x16&p0,f32x16&p1,int jb,int qrel,int hi){
  const float NEG=-INFINITY; int kb=64*jb+4*hi;
  #pragma unroll
  for(int r=0;r<16;++r){int kv=kb+(r&3)+8*(r>>2); if(kv>qrel)p0[r]=NEG; if(kv+32>qrel)p1[r]=NEG;}
}

constexpr int NSLOT=3, SLOTB=8192;
constexpr int LDS_K=0, LDS_V=NSLOT*SLOTB, LDS_WS=2*NSLOT*SLOTB, LDS_OST=LDS_WS+NW*64*4, LDS_BYTES=LDS_OST+NW*4096;
constexpr float C2=0.125f*1.4426950408889634f;
__device__ __forceinline__ void glds16(const void*gsrc,unsigned lds_dst){unsigned keep;
  asm volatile("s_mov_b32 %0, m0\n\ts_mov_b32 m0, %2\n\ts_nop 0\n\tglobal_load_lds_dwordx4 %1, off\n\ts_mov_b32 m0, %0":"=&s"(keep):"v"(gsrc),"s"(lds_dst):"memory");}
__device__ __forceinline__ float max3f(float a,float b,float c){float r;asm("v_max3_f32 %0, %1, %2, %3":"=v"(r):"v"(a),"v"(b),"v"(c));return r;}
__device__ __forceinline__ float max2f(float a,float b){float r;asm("v_max_f32_e32 %0, %1, %2":"=v"(r):"v"(a),"v"(b));return r;}
__device__ __forceinline__ float fadd_s(float a,float b){float r;asm("v_add_f32_e32 %0, %1, %2":"=v"(r):"v"(a),"v"(b));return r;}
__device__ __forceinline__ float fsub_s(float a,float b){float r;asm("v_sub_f32_e32 %0, %1, %2":"=v"(r):"v"(a),"v"(b));return r;}
typedef float f32x2_t __attribute__((ext_vector_type(2))); typedef __bf16 bf16x2_t __attribute__((ext_vector_type(2)));
__device__ __forceinline__ unsigned cvtpk_s(float lo,float hi){f32x2_t v={lo,hi};bf16x2_t b=__builtin_convertvector(v,bf16x2_t);return __builtin_bit_cast(unsigned,b);}
#define WAIT_BAR(N) asm volatile("s_waitcnt vmcnt(" #N ") lgkmcnt(0)\n\ts_barrier":::"memory")

__device__ __forceinline__ void qkt(f32x16&p0,f32x16&p1,const char*Kslot,const bf16x8*qr,const f32x16&negm,int r32,int hi){
  const char*kb=Kslot+hi*1024+r32*16;
  #pragma unroll
  for(int d0=0;d0<4;++d0){
    const bf16x8 b0=*reinterpret_cast<const bf16x8*>(kb+d0*2048);
    const bf16x8 b1=*reinterpret_cast<const bf16x8*>(kb+d0*2048+512);
    if(d0==0){p0=__builtin_amdgcn_mfma_f32_32x32x16_bf16(b0,qr[0],negm,0,0,0);p1=__builtin_amdgcn_mfma_f32_32x32x16_bf16(b1,qr[0],negm,0,0,0);}
    else{p0=__builtin_amdgcn_mfma_f32_32x32x16_bf16(b0,qr[d0],p0,0,0,0);p1=__builtin_amdgcn_mfma_f32_32x32x16_bf16(b1,qr[d0],p1,0,0,0);}}
}
typedef __attribute__((address_space(3))) const char* lds_cptr;
typedef short v4i16_t __attribute__((ext_vector_type(4)));
__device__ __forceinline__ void kload8(bf16x8*kf,lds_cptr kp){
  kf[0]=*(const __attribute__((address_space(3))) bf16x8*)(kp);      kf[1]=*(const __attribute__((address_space(3))) bf16x8*)(kp+512);
  kf[2]=*(const __attribute__((address_space(3))) bf16x8*)(kp+2048); kf[3]=*(const __attribute__((address_space(3))) bf16x8*)(kp+2560);
  kf[4]=*(const __attribute__((address_space(3))) bf16x8*)(kp+4096); kf[5]=*(const __attribute__((address_space(3))) bf16x8*)(kp+4608);
  kf[6]=*(const __attribute__((address_space(3))) bf16x8*)(kp+6144); kf[7]=*(const __attribute__((address_space(3))) bf16x8*)(kp+6656);
}
__device__ __forceinline__ void kload2(bf16x8*kf,lds_cptr kp,int j){ kf[2*j]=*(const __attribute__((address_space(3))) bf16x8*)(kp+j*2048); kf[2*j+1]=*(const __attribute__((address_space(3))) bf16x8*)(kp+j*2048+512); }
__device__ __forceinline__ s16x4 vtr(lds_cptr p){ return __builtin_bit_cast(s16x4,__builtin_amdgcn_ds_read_tr16_b64_v4i16((__attribute__((address_space(3))) v4i16_t*)p)); }
__device__ __forceinline__ float rowmax(const f32x16&p0,const f32x16&p1){
  float a=max3f(p0[0],p0[1],p1[0]),b=max3f(p0[2],p0[3],p1[1]);a=max3f(a,p1[2],p1[3]);
  #pragma unroll
  for(int r=4;r<16;r+=4){a=max3f(a,p0[r],p0[r+1]);b=max3f(b,p0[r+2],p0[r+3]);a=max3f(a,p1[r],p1[r+1]);b=max3f(b,p1[r+2],p1[r+3]);}
  const float m=max2f(a,b);
  auto rr=__builtin_amdgcn_permlane32_swap(__float_as_uint(m),__float_as_uint(m),false,false);
  return max2f(__uint_as_float(rr[0]),__uint_as_float(rr[1]));
}
__device__ __forceinline__ void pv(f32x16*o,int vb,bf16x8 pa0,bf16x8 pa1,bf16x8 pa2,bf16x8 pa3){
  #pragma unroll
  for(int d0=0;d0<2;++d0){s16x4 lo[4],hi[4];
    #pragma unroll
    for(int ks=0;ks<4;++ks){
      asm volatile("ds_read_b64_tr_b16 %0,%1 offset:%c2":"=&v"(lo[ks]):"v"(vb),"i"(d0*4096+ks*1024):"memory");
      asm volatile("ds_read_b64_tr_b16 %0,%1 offset:%c2":"=&v"(hi[ks]):"v"(vb),"i"(d0*4096+ks*1024+512):"memory");}
    asm volatile("s_waitcnt lgkmcnt(0)":::"memory");SBAR();
    #define PK(k) (bf16x8){lo[k][0],lo[k][1],lo[k][2],lo[k][3],hi[k][0],hi[k][1],hi[k][2],hi[k][3]}
    o[d0]=__builtin_amdgcn_mfma_f32_32x32x16_bf16(pa0,PK(0),o[d0],0,0,0);
    o[d0]=__builtin_amdgcn_mfma_f32_32x32x16_bf16(pa1,PK(1),o[d0],0,0,0);
    o[d0]=__builtin_amdgcn_mfma_f32_32x32x16_bf16(pa2,PK(2),o[d0],0,0,0);
    o[d0]=__builtin_amdgcn_mfma_f32_32x32x16_bf16(pa3,PK(3),o[d0],0,0,0);
    #undef PK
  }
}

#ifndef ATTN_STORE16
#define ATTN_STORE16(p,v) (*(u32x4*)(p)=(v))
#endif
template<int THRL> __device__ __forceinline__ void attn_unit(const bf16*Qu,const bf16*__restrict__ Kh,const bf16*__restrict__ Vh,bf16*Ou,const int NT,char*shm){
  int tid_l=threadIdx.x; asm volatile("":"+v"(tid_l)); const int tid=tid_l,lane=tid&63,r32=lane&31,hi=lane>>5; const int wid=__builtin_amdgcn_readfirstlane(tid>>6);
  const bf16*Qw=Qu+(long)(wid*QBLK)*DM;
  const unsigned lds0=(unsigned)(uintptr_t)shm;
  float*wsf=(float*)(shm+LDS_WS)+wid*64;
  const bf16*ksrc=Kh+(long)lane*DM+wid*8;
  const bf16*vsrc=Vh+(long)(16*(wid&3)+(lane>>2))*DM+(wid>>2)*32+(lane&3)*8;
  const unsigned kdst=lds0+LDS_K+wid*1024, vdst=lds0+LDS_V+wid*1024;
  #define DMA_K(t,slot) glds16(ksrc+(long)(t)*KVBLK*DM,(unsigned)__builtin_amdgcn_readfirstlane(kdst+(slot)))
  #define DMA_V(t,slot) glds16(vsrc+(long)(t)*KVBLK*DM,(unsigned)__builtin_amdgcn_readfirstlane(vdst+(slot)))
  const int vb0=(int)(lds0+LDS_V)+((lane>>4)&1)*32+(lane&3)*8+(4*hi+((lane&15)>>2))*64;
  const char*Kbase=shm+LDS_K; bf16x8 kf[8];
  const lds_cptr shm3=(lds_cptr)shm; const lds_cptr kp0=shm3+LDS_K+hi*1024+r32*16; const lds_cptr vp0=shm3+LDS_V+((lane>>4)&1)*32+(lane&3)*8+(4*hi+((lane&15)>>2))*64;
  DMA_K(0,0);DMA_V(0,0);DMA_K(1,SLOTB);
  bf16x8 qr[4];
  #pragma unroll
  for(int d0=0;d0<4;++d0)qr[d0]=*reinterpret_cast<const bf16x8*>(&Qw[(long)r32*DM+d0*16+hi*8]);
  float mhat=0.f,l_reg=0.f;f32x16 o[2];o[0]=f32x16{};o[1]=f32x16{};f32x16 negm=f32x16{};asm volatile("":"+v"(negm));
  #define CMASK(P0,P1,t) do{}while(0)
  bool resc=false;
  #define START(P0,P1) do{ const float rm=rowmax(P0,P1); resc=false; \
    { const float dl=rm; mhat=fadd_s(mhat,dl); \
      _Pragma("unroll") for(int r=0;r<16;++r){P0[r]=fsub_s(P0[r],dl);P1[r]=fsub_s(P1[r],dl);} \
      _Pragma("unroll") for(int r=0;r<16;++r)negm[r]=-mhat; asm volatile("":"+v"(negm)); } \
    _Pragma("unroll") for(int r=0;r<16;++r)P0[r]=__builtin_amdgcn_exp2f(P0[r]); }while(0)
  #define RESC() do{ if(resc){ asm volatile("s_waitcnt lgkmcnt(0)":::"memory"); \
      _Pragma("unroll") for(int d_=0;d_<2;++d_) _Pragma("unroll") for(int r=0;r<16;++r)o[d_][r]*=wsf[crow(r,hi)]; } }while(0)
  f32x16 pA0,pA1,pB0,pB1;
  int sl_prev=0,sl_cur=0,sl_next=SLOTB;
  #define ROT() do{sl_prev=sl_cur;sl_cur=sl_next;sl_next=(sl_next==(NSLOT-1)*SLOTB)?0:sl_next+SLOTB;}while(0)
  DMA_K(2,2*SLOTB);
  WAIT_BAR(3);
  qkt(pA0,pA1,Kbase,qr,negm,r32,hi);asm volatile("s_nop 15\n\ts_nop 7":"+v"(pA0),"+v"(pA1));CMASK(pA0,pA1,0);
  START(pA0,pA1);
  _Pragma("unroll") for(int r=0;r<16;++r)pA1[r]=__builtin_amdgcn_exp2f(pA1[r]);
  WAIT_BAR(0);
  DMA_K(3,0);DMA_V(1,SLOTB);
  ROT();
  kload8(kf,kp0+sl_cur);
  WAIT_BAR(2);
  s16x4 vlo[8],vhi[8]; u32x4 pw0,pw1,pw2,pw3;
  #define PKW(P,B) cvtpk_s(P[B],P[B+1])
  #define PAF(k) __builtin_bit_cast(bf16x8,pw##k)
  #define VFR(i) (bf16x8){vlo[i][0],vlo[i][1],vlo[i][2],vlo[i][3],vhi[i][0],vhi[i][1],vhi[i][2],vhi[i][3]}
  #define PIN(x) asm volatile("":"+v"(x))
  #define MX3(a,b,c) __builtin_fmaxf(__builtin_fmaxf((a),(b)),(c))
  #define GAPA(MF,A0,A1,A2,A3,W0,W1,PW) do{ MF; sacc+=A0; sacc+=A1; sacc+=A2; sacc+=A3; PIN(sacc); W0; W1; PIN(PW); SBAR(); }while(0)
  #define EX(v) __builtin_amdgcn_exp2f(v)
  #define GAPB(MF,X,B) do{ MF; X[B]=EX(X[B]); X[B+1]=EX(X[B+1]); X[B+2]=EX(X[B+2]); X[B+3]=EX(X[B+3]); PIN(X); SBAR(); }while(0)
  #define VRD(i) do{ vlo[i]=vtr(vp_+(((i)>>2)*4096+((i)&3)*1024)); vhi[i]=vtr(vp_+(((i)>>2)*4096+((i)&3)*1024+512)); }while(0)
  #define KRD(G,j) do{ if(G){ kload2(kf,kp0+sl_next,j); SBAR(); } }while(0)
  #define STEP(C0,C1,P0,P1,t,GK,GV,GL) do{ SBAR(); \
    const lds_cptr vp_=vp0+sl_prev; \
    VRD(0); SBAR(); float sacc=(P0[0]+P0[1]); \
    GAPA(C0=__builtin_amdgcn_mfma_f32_32x32x16_bf16(kf[0],qr[0],negm,0,0,0), P0[2],P0[3],P0[4],P0[5],     pw0[0]=PKW(P0,0), pw0[1]=PKW(P0,2), pw0); \
    VRD(4); SBAR(); GAPA(C1=__builtin_amdgcn_mfma_f32_32x32x16_bf16(kf[1],qr[0],negm,0,0,0), P0[6],P0[7],P0[8],P0[9],     pw0[2]=PKW(P0,4), pw0[3]=PKW(P0,6), pw0); \
    VRD(1); SBAR(); GAPA(C0=__builtin_amdgcn_mfma_f32_32x32x16_bf16(kf[2],qr[1],C0,0,0,0),   P0[10],P0[11],P0[12],P0[13], pw1[0]=PKW(P0,8), pw1[1]=PKW(P0,10), pw1); \
    VRD(5); SBAR(); GAPA(C1=__builtin_amdgcn_mfma_f32_32x32x16_bf16(kf[3],qr[1],C1,0,0,0),   P0[14],P0[15],P1[0],P1[1],   pw1[2]=PKW(P0,12),pw1[3]=PKW(P0,14), pw1); \
    VRD(2); SBAR(); GAPA(C0=__builtin_amdgcn_mfma_f32_32x32x16_bf16(kf[4],qr[2],C0,0,0,0),   P1[2],P1[3],P1[4],P1[5],     pw2[0]=PKW(P1,0), pw2[1]=PKW(P1,2), pw2); \
    VRD(6); SBAR(); GAPA(C1=__builtin_amdgcn_mfma_f32_32x32x16_bf16(kf[5],qr[2],C1,0,0,0),   P1[6],P1[7],P1[8],P1[9],     pw2[2]=PKW(P1,4), pw2[3]=PKW(P1,6), pw2); \
    VRD(3); SBAR(); GAPA(C0=__builtin_amdgcn_mfma_f32_32x32x16_bf16(kf[6],qr[3],C0,0,0,0),   P1[10],P1[11],P1[12],P1[13], pw3[0]=PKW(P1,8), pw3[1]=PKW(P1,10), pw3); \
    VRD(7); SBAR(); GAPA(C1=__builtin_amdgcn_mfma_f32_32x32x16_bf16(kf[7],qr[3],C1,0,0,0),   P1[14],P1[15],0.f,0.f,       pw3[2]=PKW(P1,12),pw3[3]=PKW(P1,14), pw3); \
    l_reg+=sacc; \
    if(GK){DMA_K((t)+3,sl_cur);} if(GV){DMA_V((t)+1,sl_next);} \
    CMASK(C0,C1,t); \
    { float a=MX3(C0[0],C0[1],C1[0]),b=MX3(C0[2],C0[3],C1[1]); a=MX3(a,C1[2],C1[3]); \
      _Pragma("unroll") for(int r=4;r<16;r+=4){a=MX3(a,C0[r],C0[r+1]);b=MX3(b,C0[r+2],C0[r+3]);a=MX3(a,C1[r],C1[r+1]);b=MX3(b,C1[r+2],C1[r+3]);} \
      float rm=__builtin_fmaxf(a,b); { auto rr=__builtin_amdgcn_permlane32_swap(__float_as_uint(rm),__float_as_uint(rm),false,false); rm=__builtin_fmaxf(__uint_as_float(rr[0]),__uint_as_float(rr[1])); } \
      resc=false; \
      if(__builtin_expect(__any(rm>(float)THRL),0)){ const float dl=__builtin_fmaxf(rm,0.f); mhat+=dl; \
        _Pragma("unroll") for(int r=0;r<16;++r){C0[r]-=dl;C1[r]-=dl;} \
        _Pragma("unroll") for(int r=0;r<16;++r)negm[r]=-mhat; asm volatile("":"+v"(negm)); \
        const float f=__builtin_amdgcn_exp2f(-dl); l_reg*=f; if(hi==0)wsf[r32]=f; resc=true; } } \
    SBAR(); \
    GAPB(o[0]=__builtin_amdgcn_mfma_f32_32x32x16_bf16(PAF(0),VFR(0),o[0],0,0,0), C0,0); \
    GAPB(o[1]=__builtin_amdgcn_mfma_f32_32x32x16_bf16(PAF(0),VFR(4),o[1],0,0,0), C0,4); \
    KRD(GL,0); GAPB(o[0]=__builtin_amdgcn_mfma_f32_32x32x16_bf16(PAF(1),VFR(1),o[0],0,0,0), C0,8); \
    KRD(GL,1); GAPB(o[1]=__builtin_amdgcn_mfma_f32_32x32x16_bf16(PAF(1),VFR(5),o[1],0,0,0), C0,12); \
    KRD(GL,2); GAPB(o[0]=__builtin_amdgcn_mfma_f32_32x32x16_bf16(PAF(2),VFR(2),o[0],0,0,0), C1,0); \
    KRD(GL,3); GAPB(o[1]=__builtin_amdgcn_mfma_f32_32x32x16_bf16(PAF(2),VFR(6),o[1],0,0,0), C1,4); \
    GAPB(o[0]=__builtin_amdgcn_mfma_f32_32x32x16_bf16(PAF(3),VFR(3),o[0],0,0,0), C1,8); \
    GAPB(o[1]=__builtin_amdgcn_mfma_f32_32x32x16_bf16(PAF(3),VFR(7),o[1],0,0,0), C1,12); \
    }while(0)
  int t=1;
  #undef CMASK
  #define CMASK(P0,P1,t) do{}while(0)
  for(;t+5<NT;t+=2){
    STEP(pB0,pB1,pA0,pA1,t,true,true,true);     WAIT_BAR(2); RESC(); ROT();
    STEP(pA0,pA1,pB0,pB1,t+1,true,true,true);   WAIT_BAR(2); RESC(); ROT();
  }
  #undef CMASK
  #define CMASK(P0,P1,t) do{}while(0)
  #define ENDW(tt) do{ if((tt)+3<NT){WAIT_BAR(2);} else if((tt)+2<NT){WAIT_BAR(1);} else {WAIT_BAR(0);} }while(0)
  for(;t+1<NT;t+=2){
    STEP(pB0,pB1,pA0,pA1,t,(t+3<NT),(t+1<NT),(t+1<NT));       ENDW(t);   RESC(); ROT();
    STEP(pA0,pA1,pB0,pB1,t+1,(t+4<NT),(t+2<NT),(t+2<NT));     ENDW(t+1); RESC(); ROT();
  }
  STEP(pB0,pB1,pA0,pA1,NT-1,false,false,false); RESC();
  { float sacc=pB0[0]+pB0[1]; _Pragma("unroll") for(int r=2;r<16;++r)sacc+=pB0[r]; _Pragma("unroll") for(int r=0;r<16;++r)sacc+=pB1[r]; l_reg+=sacc;
    pw0=(u32x4){PKW(pB0,0),PKW(pB0,2),PKW(pB0,4),PKW(pB0,6)};pw1=(u32x4){PKW(pB0,8),PKW(pB0,10),PKW(pB0,12),PKW(pB0,14)};pw2=(u32x4){PKW(pB1,0),PKW(pB1,2),PKW(pB1,4),PKW(pB1,6)};pw3=(u32x4){PKW(pB1,8),PKW(pB1,10),PKW(pB1,12),PKW(pB1,14)};
    SBAR(); pv(o,vb0+sl_cur,PAF(0),PAF(1),PAF(2),PAF(3)); }
  #undef PKW
  #undef PAF
  #undef VFR
  #undef PIN
  #undef MX3
  #undef GAPA
  #undef GAPB
  #undef EX
  #undef VRD
  #undef KRD
  #undef STEP
  #undef ENDW
  {auto rr=__builtin_amdgcn_permlane32_swap(__float_as_uint(l_reg),__float_as_uint(l_reg),false,false);l_reg=__uint_as_float(rr[0])+__uint_as_float(rr[1]);}
  if(hi==0)wsf[32+r32]=l_reg;asm volatile("s_waitcnt lgkmcnt(0)":::"memory");
  float rli[16];
  #pragma unroll
  for(int r=0;r<16;++r)rli[r]=__builtin_amdgcn_rcpf(wsf[32+crow(r,hi)]);
  bf16*Ow=Ou+(long)(wid*QBLK)*DM;
  { bf16*stg=(bf16*)(shm+LDS_OST)+wid*2048;
    #pragma unroll
    for(int r=0;r<16;++r){const int orow=crow(r,hi);
      #pragma unroll
      for(int d0=0;d0<2;++d0)stg[orow*64+d0*32+r32]=__float2bfloat16(o[d0][r]*rli[r]);}
    asm volatile("s_waitcnt lgkmcnt(0)":::"memory");
    #pragma unroll
    for(int i=0;i<4;++i){const int row=i*8+(lane>>3),ch=lane&7; const u32x4 v=*(const u32x4*)(stg+row*64+ch*8); ATTN_STORE16(Ow+(long)row*DM+ch*8,v);} }
  asm volatile("s_waitcnt lgkmcnt(0)\n\ts_barrier":::"memory");
  #undef DMA_K
  #undef DMA_V
  #undef CMASK
  #undef START
  #undef RESC
  #undef ROT
}
constexpr int ATTN_LDS_BYTES=LDS_BYTES;
#undef SBAR
#undef WAIT_BAR
}
#ifndef XB_FENCE_SCOPE
#define XB_FENCE_SCOPE "agent"
#endif
#define GAS __attribute__((address_space(1)))
#define LAS __attribute__((address_space(3)))
typedef unsigned short bf16;
typedef unsigned v4u __attribute__((ext_vector_type(4)));
typedef float f32x4 __attribute__((ext_vector_type(4)));
typedef short bf16x8 __attribute__((ext_vector_type(8)));
typedef GAS unsigned gu32;
typedef GAS unsigned long long gu64;
#define RLX_AGENT __ATOMIC_RELAXED, __HIP_MEMORY_SCOPE_AGENT
#define LDS_WAIT() asm volatile("s_waitcnt lgkmcnt(0)" ::: "memory")
#define VM_WAIT() asm volatile("s_waitcnt vmcnt(0)" ::: "memory")
__device__ __forceinline__ unsigned long long rt() { return __builtin_amdgcn_s_memrealtime(); }
__device__ __forceinline__ unsigned f2bf(float f) { unsigned u = __builtin_bit_cast(unsigned, f); return (u + 0x7fffu + ((u >> 16) & 1u)) >> 16; }
__device__ __forceinline__ unsigned pk2(float lo, float hi) { typedef float pkf2_ __attribute__((ext_vector_type(2))); typedef __bf16 pkb2_ __attribute__((ext_vector_type(2))); const pkf2_ v = {lo, hi}; return __builtin_bit_cast(unsigned, __builtin_convertvector(v, pkb2_)); }

#define XB_TMO      128
#define XB_XCNT(j)  (256  + 64 * (j))
#define XB_XSUB(j)  (1280 + 64 * (j))
#define XB_XGEN(j)  (2304 + 64 * (j))
#define XB_TOP      3328
#define XB_TOPGEN   3392
#define XCD_BAR_WORDS 3456
#define XB_SPIN_CAP (1u << 25)

__device__ __forceinline__ unsigned xb_ld(unsigned* p)              { return __hip_atomic_load(p, __ATOMIC_RELAXED, __HIP_MEMORY_SCOPE_AGENT); }
__device__ __forceinline__ unsigned xb_add(unsigned* p, unsigned v) { return __hip_atomic_fetch_add(p, v, __ATOMIC_RELAXED, __HIP_MEMORY_SCOPE_AGENT); }
__device__ __forceinline__ unsigned xb_xcc_id() { return (unsigned)__builtin_amdgcn_s_getreg((3 << 11) | 20) & 0xFu; }
#define XB_SPIN(cond, bar) do { unsigned _sp = 0; while (cond) { __builtin_amdgcn_s_sleep(1); \
    if ((++_sp & 255u) == 0u) { if (xb_ld(&(bar)[XB_TMO])) break; if (_sp > XB_SPIN_CAP) { atomicAdd(&(bar)[XB_TMO], 1u); break; } } } } while (0)

struct XcdBarrier {
    unsigned* bar; unsigned x;
    volatile LAS unsigned* st;
};

__device__ __forceinline__ XcdBarrier xcd_barrier_post(unsigned* bar, volatile LAS unsigned* st) {
    XcdBarrier b; b.bar = bar; b.x = xb_xcc_id(); b.st = st;
    if (threadIdx.x == 0) (void)xb_add(&bar[XB_XCNT(b.x)], 1u);
    return b;
}
__device__ __forceinline__ void xcd_barrier_complete(unsigned* bar, unsigned x, unsigned& nloc, unsigned& nx) {
    const unsigned G = gridDim.x * gridDim.y * gridDim.z;
    unsigned sum, cnt, mine, sp = 0u;
    for (;;) {
        sum = 0u; cnt = 0u; mine = 0u;
#pragma unroll
        for (unsigned j = 0; j < 16; ++j) { const unsigned c = xb_ld(&bar[XB_XCNT(j)]); sum += c; cnt += (c > 0u) ? 1u : 0u; mine = (j == x) ? c : mine; }
        if (sum == G) break;
        __builtin_amdgcn_s_sleep(1);
        if ((++sp & 255u) == 0u) { if (xb_ld(&bar[XB_TMO])) break; if (sp > XB_SPIN_CAP) { atomicAdd(&bar[XB_TMO], 1u); break; } }
    }
    nloc = mine > 0u ? mine : 1u; nx = cnt > 0u ? cnt : 1u;
}

__device__ __forceinline__ void xcd_barrier(const XcdBarrier& b) {
    asm volatile("s_waitcnt vmcnt(0)" ::: "memory");
    __syncthreads();
    if (threadIdx.x == 0) {
        unsigned* bar = b.bar;
        __builtin_amdgcn_s_waitcnt(0);
        unsigned nloc = b.st[0], nx = b.st[1];
        if (nloc == 0u) { xcd_barrier_complete(bar, b.x, nloc, nx); b.st[0] = nloc; b.st[1] = nx; }
        const unsigned old = xb_add(&bar[XB_XSUB(b.x)], 1u);
        const unsigned gen = old / nloc;
        if (old + 1u == (gen + 1u) * nloc) {
            __builtin_amdgcn_fence(__ATOMIC_RELEASE, XB_FENCE_SCOPE);
            asm volatile("s_waitcnt vmcnt(0)" ::: "memory");
            const unsigned og = xb_add(&bar[XB_TOP], 1u);
            const unsigned tg = og / nx;
            if (og + 1u == (tg + 1u) * nx) xb_add(&bar[XB_TOPGEN], 1u);
            else XB_SPIN(xb_ld(&bar[XB_TOPGEN]) == tg, bar);
            __builtin_amdgcn_fence(__ATOMIC_ACQUIRE, XB_FENCE_SCOPE);
            xb_add(&bar[XB_XGEN(b.x)], 1u);
            asm volatile("s_waitcnt vmcnt(0)" ::: "memory");
        } else {
            XB_SPIN(xb_ld(&bar[XB_XGEN(b.x)]) == gen, bar);
            __builtin_amdgcn_fence(__ATOMIC_ACQUIRE, XB_FENCE_SCOPE);
            asm volatile("s_waitcnt vmcnt(0)" ::: "memory");
        }
    }
    __syncthreads();
}

constexpr size_t MiB = 1u << 20;
constexpr size_t WS_CTL = 0, CTL_ZERO_BYTES = 1 * MiB;
constexpr size_t WS_MOD = 1 * MiB;
constexpr size_t WS_S5A = WS_MOD + 512 * 1024;
constexpr size_t WS_S5B = 2 * MiB;
constexpr size_t WS_ROPE = 3 * MiB;
constexpr size_t WS_WIN = 4 * MiB;
constexpr size_t WS_WGLU = 30 * MiB;
constexpr size_t WS_WBR = 31 * MiB;
constexpr size_t WS_WOUT = 37 * MiB;
constexpr size_t WS_WQ = 41 * MiB;
constexpr size_t WS_TAB = 49 * MiB;
constexpr size_t WS_STRM = 113 * MiB;
constexpr size_t WS_HA = 185 * MiB;
constexpr size_t WS_YDIR = 221 * MiB;
constexpr size_t WS_PROJ = 257 * MiB;
constexpr size_t WS_SC = WS_PROJ, WS_EIDX = WS_PROJ + 144 * MiB, WS_GATE = WS_PROJ + 153 * MiB;
constexpr size_t WS_MLN = 491 * MiB, WS_MLB = 492 * MiB, WS_S5CF = 492 * MiB + 65536, WS_SCT = 492 * MiB + 655360;
constexpr size_t WS_END = 493 * MiB;
static_assert(WS_PROJ + (size_t)MROWS * PW * 2 <= WS_END && WS_END <= 512 * MiB, "ws map");
constexpr int CW_BAR = 4096;
#ifndef SHIFT_N
#define SHIFT_N 0
#endif
#define SHIFT_STR2(x) #x
#define SHIFT_STR(x) SHIFT_STR2(x)
#define SHIFT_HERE() do { if (SHIFT_N > 0) asm volatile(".rept " SHIFT_STR(SHIFT_N) "\n\ts_nop 0\n\t.endr" ::: "memory"); } while (0)
#ifndef SHIFT_POS
#define SHIFT_POS -1
#endif
#ifndef S5_PIN_NOPS
#define S5_PIN_NOPS 0
#endif
#define SHIFT_AT(k) do { if (SHIFT_POS == (k)) asm volatile("s_nop 0"); } while (0)
#ifndef DOUBLE_BAR
#define DOUBLE_BAR 0
#endif

constexpr int RING_BYTES = 131072, LDSCTL_OFF = RING_BYTES, MISC_OFF = LDSCTL_OFF + 320, LDS_BYTES = 147456;
constexpr int NWAVES = 8;
constexpr float ATT_C2 = 0.125f * 1.4426950408889634f;

typedef unsigned u32x2 __attribute__((ext_vector_type(2)));
typedef float f32x2 __attribute__((ext_vector_type(2)));

__device__ __forceinline__ float bf2f(unsigned short u) { return __uint_as_float((unsigned)u << 16); }
__device__ __forceinline__ float bflo(unsigned w) { return __uint_as_float(w << 16); }
__device__ __forceinline__ float bfhi(unsigned w) { return __uint_as_float(w & 0xffff0000u); }
__device__ __forceinline__ float gelu_tanh(float x) { const float u = 1.5957691216057308f * (x + 0.044715f * x * x * x); return x * __builtin_amdgcn_rcpf(1.f + __expf(-u)); }
__device__ __forceinline__ float sigm(float x) { return __builtin_amdgcn_rcpf(1.f + __expf(-x)); }
__device__ __forceinline__ float log_sigmoid(float x) { const float z = __expf(-fabsf(x)); return fminf(x, 0.f) - __logf(1.f + z); }
__device__ __forceinline__ float wave_sum(float v) {
#pragma unroll
    for (int o = 1; o < 64; o <<= 1) v += __shfl_xor(v, o);
    return v;
}
__device__ __forceinline__ int seqmap(int p, int dir) { return dir == 0 ? p : (p < NCTX ? (NCTX - 1 - p) : (SB + NCTX - 1 - p)); }
typedef __bf16 bf16x2_t __attribute__((ext_vector_type(2)));
__device__ __forceinline__ float dot2bf(unsigned a, unsigned b, float c) { return __builtin_amdgcn_fdot2_f32_bf16(__builtin_bit_cast(bf16x2_t, a), __builtin_bit_cast(bf16x2_t, b), c, false); }

struct Args { const float* in[32]; float* out; unsigned char* ws; };
typedef const __attribute__((address_space(4))) Args* KArgsP;
struct Ctx { int tid, lane, wave, vcu, G; LAS unsigned char* lds; unsigned char* ws; };

struct RowOrder {
    pg8::StaticOrder S; int latent;
    __host__ __device__ void init(int latent_, int N, int G_, int c_, int rot = 0) { latent = latent_; S.init(latent_ ? NB * SEQ : MROWS, N, G_, (c_ + G_ - rot % G_) % G_); }
    __host__ __device__ bool next(int i, pg8::Unit& u) const { if (!S.next(i, u)) return false; if (latent) u.pm = 9 * (u.pm >> 3) + 1 + (u.pm & 7); return true; }
    __device__ __forceinline__ void a_ready(const pg8::Unit&) const {}
    __device__ __forceinline__ void done(const pg8::Unit&) const {}
};
struct G1Order {
    pg8::StaticOrder S; int latent, G, c;
    __host__ __device__ void init(int latent_, int G_, int c_) { latent = latent_; G = G_; c = c_; S.init(latent_ ? NB * SEQ : MROWS, PW, G_, c_); }
    __host__ __device__ bool next(int i, pg8::Unit& u) const {
        if (!latent) return S.next(i, u);
        if (S.next(i, u)) { u.pm = 9 * (u.pm >> 3) + 1 + (u.pm & 7); return true; }
        const long L = (long)i * G + c - 1664; if (L < 0 || L >= 64) return false;
        const int w = (int)L & 7; u.pm = 9 * ((int)L >> 3); u.pn = w < 2 ? w : (w == 2 ? 4 : (w < 7 ? w + 4 : 25)); return true;
    }
    __device__ __forceinline__ void a_ready(const pg8::Unit&) const {}
    __device__ __forceinline__ void done(const pg8::Unit&) const {}
};
struct EpiGlu {
    static constexpr bool PERM = true, AFTER_DRAIN = false;
    const bf16* Y; int ldy; bf16* O; int ldo;
    __device__ __forceinline__ void operator()(const pg8::f32x4 (&acc)[2][2][4][2], const pg8::Unit& u, int wr, int wc, int fr, int fq) const {
        const int row0 = u.pm * 256 + wr * 64 + fr, col0 = u.pn * 256 + wc * 32 + 8 * fq;
#pragma unroll
        for (int ai = 0; ai < 2; ++ai)
#pragma unroll
            for (int m = 0; m < 4; ++m) { const size_t row = row0 + ai * 128 + m * 16;
#pragma unroll
                for (int bj = 0; bj < 2; ++bj) { const int col = col0 + bj * 128;
                    const v4u yv = *(const v4u*)(Y + row * ldy + col); const f32x4 v0 = acc[ai][bj][m][0], v1 = acc[ai][bj][m][1];
                    v4u w; w.x = pk2(bflo(yv.x) * sigm(v0[0]), bfhi(yv.x) * sigm(v0[1])); w.y = pk2(bflo(yv.y) * sigm(v0[2]), bfhi(yv.y) * sigm(v0[3]));
                    w.z = pk2(bflo(yv.z) * sigm(v1[0]), bfhi(yv.z) * sigm(v1[1])); w.w = pk2(bflo(yv.w) * sigm(v1[2]), bfhi(yv.w) * sigm(v1[3]));
                    *(v4u*)(O + row * ldo + col) = w; } }
    }
};
struct EpiGate {
    static constexpr bool PERM = true, AFTER_DRAIN = false;
    const bf16* GL; int ldg; bf16* O; int ldo; int rmw;
    __device__ __forceinline__ void operator()(const pg8::f32x4 (&acc)[2][2][4][2], const pg8::Unit& u, int wr, int wc, int fr, int fq) const {
        const int row0 = u.pm * 256 + wr * 64 + fr, col0 = u.pn * 256 + wc * 32 + 8 * fq;
#pragma unroll
        for (int ai = 0; ai < 2; ++ai)
#pragma unroll
            for (int m = 0; m < 4; ++m) { const size_t row = row0 + ai * 128 + m * 16;
#pragma unroll
                for (int bj = 0; bj < 2; ++bj) { const int col = col0 + bj * 128;
                    const v4u gv = *(const v4u*)(GL + row * ldg + col); const f32x4 v0 = acc[ai][bj][m][0], v1 = acc[ai][bj][m][1];
                    float o0 = sigm(bflo(gv.x)) * v0[0], o1 = sigm(bfhi(gv.x)) * v0[1], o2 = sigm(bflo(gv.y)) * v0[2], o3 = sigm(bfhi(gv.y)) * v0[3];
                    float o4 = sigm(bflo(gv.z)) * v1[0], o5 = sigm(bfhi(gv.z)) * v1[1], o6 = sigm(bflo(gv.w)) * v1[2], o7 = sigm(bfhi(gv.w)) * v1[3];
                    if (rmw) { const v4u pv = *(const v4u*)(O + row * ldo + col);
                        o0 += bflo(pv.x); o1 += bfhi(pv.x); o2 += bflo(pv.y); o3 += bfhi(pv.y); o4 += bflo(pv.z); o5 += bfhi(pv.z); o6 += bflo(pv.w); o7 += bfhi(pv.w); }
                    v4u w; w.x = pk2(o0, o1); w.y = pk2(o2, o3); w.z = pk2(o4, o5); w.w = pk2(o6, o7);
                    *(v4u*)(O + row * ldo + col) = w; } }
    }
};
struct EpiResid {
    static constexpr bool PERM = false, AFTER_DRAIN = false;
    bf16* S; const float* modl; int gchunk;
    __device__ __forceinline__ void operator()(const pg8::f32x4 (&acc)[2][2][4][2], const pg8::Unit& u, int wr, int wc, int fr, int fq) const {
        const int b = u.pm / 9; const bool isctx = (u.pm % 9) == 0;
        const float* g = modl + (isctx ? 8 : b) * 6144 + gchunk * 1024;
        const int row0 = u.pm * 256 + wr * 64 + fr, col0 = u.pn * 256 + wc * 32 + 4 * fq;
#pragma unroll
        for (int bj = 0; bj < 2; ++bj)
#pragma unroll
            for (int n = 0; n < 2; ++n) { const int col = col0 + bj * 128 + n * 16; const f32x4 gv = *(const f32x4*)(g + col);
#pragma unroll
                for (int ai = 0; ai < 2; ++ai)
#pragma unroll
                    for (int m = 0; m < 4; ++m) { bf16* p = S + (size_t)(row0 + ai * 128 + m * 16) * DM_ + col; const u32x2 o = *(const u32x2*)p; const f32x4 a = acc[ai][bj][m][n];
                        u32x2 w; w.x = pk2(bflo(o.x) + gv[0] * a[0], bfhi(o.x) + gv[1] * a[1]); w.y = pk2(bflo(o.y) + gv[2] * a[2], bfhi(o.y) + gv[3] * a[3]); *(u32x2*)p = w; } }
    }
};
struct EpiF32 {
    static constexpr bool PERM = false, AFTER_DRAIN = false;
    float* O; int ldo;
    __device__ __forceinline__ void operator()(const pg8::f32x4 (&acc)[2][2][4][2], const pg8::Unit& u, int wr, int wc, int fr, int fq) const {
        const int row0 = u.pm * 256 + wr * 64 + fr, col0 = u.pn * 256 + wc * 32 + 4 * fq;
#pragma unroll
        for (int ai = 0; ai < 2; ++ai)
#pragma unroll
            for (int m = 0; m < 4; ++m)
#pragma unroll
                for (int bj = 0; bj < 2; ++bj)
#pragma unroll
                    for (int n = 0; n < 2; ++n) *(f32x4*)(O + (size_t)(row0 + ai * 128 + m * 16) * ldo + col0 + bj * 128 + n * 16) = acc[ai][bj][m][n];
    }
};

__device__ __forceinline__ void transpose_item(const float* W, int K, int N, bf16* WT, int k0, int n0, int ns0, int nvalid, LAS float* scr, int lane) {
    float tv_[32];
#pragma unroll
    for (int i = 0; i < 32; ++i) { const int kk = 2 * i + (lane >> 5); const int c = lane & 31; tv_[i] = c < nvalid ? W[(size_t)(k0 + kk) * N + ns0 + c] : 0.f; }
#pragma unroll
    for (int i = 0; i < 32; ++i) { const int kk = 2 * i + (lane >> 5); const int c = lane & 31; scr[kk * 33 + c] = tv_[i]; }
    LDS_WAIT(); asm volatile("" ::: "memory");
    const int c = lane & 7;
#pragma unroll
    for (int j = 0; j < 4; ++j) { const int n = (lane >> 3) + 8 * j; const LAS float* s = scr + (8 * c) * 33 + n;
        v4u o; o.x = pk2(s[0 * 33], s[1 * 33]); o.y = pk2(s[2 * 33], s[3 * 33]); o.z = pk2(s[4 * 33], s[5 * 33]); o.w = pk2(s[6 * 33], s[7 * 33]);
        *(GAS v4u*)(WT + (size_t)(n0 + n) * K + k0 + 8 * c) = o; }
    LDS_WAIT(); asm volatile("" ::: "memory");
}
__device__ __forceinline__ void transpose_plain(const float* W, int K, int N, bf16* WT, int item, LAS float* scr, int lane) {
    const int nblk = N / 32, kb = item / nblk, nb = item % nblk;
    transpose_item(W, K, N, WT, 64 * kb, 32 * nb, 32 * nb, 32, scr, lane);
}
__device__ __forceinline__ void transpose_win(const float* W, bf16* WT, int item, LAS float* scr, int lane) {
    const int nblk = PW / 32, kb = item / nblk, nb = item % nblk, n0 = 32 * nb;
    int ns0, nv;
    if (n0 < PC_GL) { ns0 = n0; nv = 32; } else if (n0 < PC_GM) { ns0 = n0 + 16; nv = 32; } else if (n0 == PC_GM) { ns0 = 3328; nv = 16; } else { ns0 = 0; nv = 0; }
    transpose_item(W, DM_, INW, WT, 64 * kb, n0, ns0, nv, scr, lane);
}
__device__ __forceinline__ void convert_stream(const float* src, bf16* dst, size_t n, size_t gtid, size_t nthr) {
    for (size_t i = gtid; i < n / 8; i += nthr) { const f32x4 a = ((const f32x4*)src)[2 * i], b = ((const f32x4*)src)[2 * i + 1];
        v4u o; o.x = pk2(a[0], a[1]); o.y = pk2(a[2], a[3]); o.z = pk2(b[0], b[1]); o.w = pk2(b[2], b[3]); ((v4u*)dst)[i] = o; }
}

__device__ __forceinline__ void convert_stream_fp8(const float* src, unsigned char* dst, size_t n, float scale, size_t gtid, size_t nthr) {
    for (size_t i = gtid; i < n / 16; i += nthr) { const f32x4 a = ((const f32x4*)src)[4 * i] * scale, b = ((const f32x4*)src)[4 * i + 1] * scale, c = ((const f32x4*)src)[4 * i + 2] * scale, d = ((const f32x4*)src)[4 * i + 3] * scale;
        v4u o; int w;
        w = __builtin_amdgcn_cvt_pk_fp8_f32(a[0], a[1], 0, false); w = __builtin_amdgcn_cvt_pk_fp8_f32(a[2], a[3], w, true); o.x = (unsigned)w;
        w = __builtin_amdgcn_cvt_pk_fp8_f32(b[0], b[1], 0, false); w = __builtin_amdgcn_cvt_pk_fp8_f32(b[2], b[3], w, true); o.y = (unsigned)w;
        w = __builtin_amdgcn_cvt_pk_fp8_f32(c[0], c[1], 0, false); w = __builtin_amdgcn_cvt_pk_fp8_f32(c[2], c[3], w, true); o.z = (unsigned)w;
        w = __builtin_amdgcn_cvt_pk_fp8_f32(d[0], d[1], 0, false); w = __builtin_amdgcn_cvt_pk_fp8_f32(d[2], d[3], w, true); o.w = (unsigned)w;
        *(v4u*)(dst + (i >> 6) * 2048 + (i & 63) * 16) = o; }
}
typedef unsigned v6u __attribute__((ext_vector_type(6)));
typedef float v16f __attribute__((ext_vector_type(16)));
typedef float v32f __attribute__((ext_vector_type(32)));
constexpr int F6_REC = 1536;
#ifndef F6_INTERLEAVED
#define F6_INTERLEAVED 1
#endif
__device__ __forceinline__ constexpr int f6_dim(int j) { return F6_INTERLEAVED ? ((j & 1) ? 16 + (j >> 1) : (j >> 1)) : j; }
__device__ __forceinline__ void convert_rows_fp6(const float* pu, const float* pv, unsigned char* tab, float2* sct, size_t gt, size_t nt) {
    const int lane = (int)(gt & 63), L = lane & 31; const size_t w0 = gt >> 6, nw = nt >> 6;
    for (size_t rp = w0; rp < 8192; rp += nw) {
        const size_t e = 2 * rp + (lane >> 5);
        float sc[2];
#pragma unroll
        for (int uv = 0; uv < 2; ++uv) {
            const f32x4* src = (const f32x4*)((uv ? pv : pu) + e * 1024 + 32 * L);
            f32x4 a[8];
#pragma unroll
            for (int i = 0; i < 8; ++i) a[i] = src[i];
            float mx = 0.f;
#pragma unroll
            for (int i = 0; i < 8; ++i) mx = fmaxf(fmaxf(mx, fmaxf(fabsf(a[i][0]), fabsf(a[i][1]))), fmaxf(fabsf(a[i][2]), fabsf(a[i][3])));
            mx = fmaxf(mx, __shfl_xor(mx, 1)); mx = fmaxf(mx, __shfl_xor(mx, 2)); mx = fmaxf(mx, __shfl_xor(mx, 4)); mx = fmaxf(mx, __shfl_xor(mx, 8)); mx = fmaxf(mx, __shfl_xor(mx, 16));
            const float s = fmaxf(mx, 1e-30f) * (1.f / 7.5f), inv = 1.f / s; sc[uv] = s;
            v16f lo, hi;
#pragma unroll
            for (int i = 0; i < 16; ++i) { lo[i] = a[i >> 2][i & 3] * inv; hi[i] = a[4 + (i >> 2)][i & 3] * inv; }
            const v6u w = __builtin_amdgcn_cvt_scalef32_2xpk16_fp6_f32(lo, hi, 1.f);
#ifdef F6_DIAG
            if (rp == 0 && uv == 0) {
                const v32f dec = __builtin_amdgcn_cvt_scalef32_pk32_f32_fp6(w, 1.f);
                typedef __bf16 bf32d_t __attribute__((ext_vector_type(32))); typedef unsigned v16ud_t __attribute__((ext_vector_type(16)));
                const v16ud_t db = __builtin_bit_cast(v16ud_t, __builtin_amdgcn_cvt_scalef32_pk32_bf16_fp6(w, 1.f));
                float eA = 0.f, eB = 0.f, eC = 0.f;
#pragma unroll
                for (int j = 0; j < 32; ++j) { eA = fmaxf(eA, fabsf(dec[j] - ((j & 1) ? hi[j >> 1] : lo[j >> 1]))); eB = fmaxf(eB, fabsf(dec[j] - (j < 16 ? lo[j] : hi[j - 16])));
                    const float bj = (j & 1) ? __uint_as_float(db[j >> 1] & 0xffff0000u) : __uint_as_float(db[j >> 1] << 16); eC = fmaxf(eC, fabsf(bj - dec[j])); }
#pragma unroll
                for (int o = 1; o < 64; o <<= 1) { eA = fmaxf(eA, __shfl_xor(eA, o)); eB = fmaxf(eB, __shfl_xor(eB, o)); eC = fmaxf(eC, __shfl_xor(eC, o)); }
                if (lane == 0) { float* dg = (float*)sct + 2 * 32768; dg[0] = eA; dg[1] = eB; dg[2] = eC; }
            }
#endif
            unsigned char* rec = tab + e * F6_REC + uv * 768;
            *(v4u*)(rec + L * 16) = v4u{w[0], w[1], w[2], w[3]}; *(u32x2*)(rec + 512 + L * 8) = u32x2{w[4], w[5]};
        }
        if (L == 0) sct[e] = make_float2(sc[0], sc[1]);
    }
}
#ifdef PEER_FP4
constexpr int F4_REC = 1024;
__device__ __forceinline__ void convert_rows_fp4(const float* pu, const float* pv, unsigned char* tab, float2* sct, size_t gt, size_t nt) {
    const int lane = (int)(gt & 63), L = lane & 31; const size_t w0 = gt >> 6, nw = nt >> 6;
    for (size_t rp = w0; rp < 8192; rp += nw) {
        const size_t e = 2 * rp + (lane >> 5);
        float sc[2];
#pragma unroll
        for (int uv = 0; uv < 2; ++uv) {
            const f32x4* src = (const f32x4*)((uv ? pv : pu) + e * 1024 + 32 * L);
            f32x4 a[8];
#pragma unroll
            for (int i = 0; i < 8; ++i) a[i] = src[i];
            float mx = 0.f;
#pragma unroll
            for (int i = 0; i < 8; ++i) mx = fmaxf(fmaxf(mx, fmaxf(fabsf(a[i][0]), fabsf(a[i][1]))), fmaxf(fabsf(a[i][2]), fabsf(a[i][3])));
            mx = fmaxf(mx, __shfl_xor(mx, 1)); mx = fmaxf(mx, __shfl_xor(mx, 2)); mx = fmaxf(mx, __shfl_xor(mx, 4)); mx = fmaxf(mx, __shfl_xor(mx, 8)); mx = fmaxf(mx, __shfl_xor(mx, 16));
            const float s = fmaxf(mx, 1e-30f) * (1.f / 6.f), inv = 1.f / s; sc[uv] = s;
            unsigned w[4];
#pragma unroll
            for (int d = 0; d < 4; ++d) { unsigned t = 0u;
                t = __builtin_amdgcn_cvt_scalef32_pk_fp4_f32(t, a[2 * d][0] * inv, a[2 * d][1] * inv, 1.f, 0); t = __builtin_amdgcn_cvt_scalef32_pk_fp4_f32(t, a[2 * d][2] * inv, a[2 * d][3] * inv, 1.f, 1);
                t = __builtin_amdgcn_cvt_scalef32_pk_fp4_f32(t, a[2 * d + 1][0] * inv, a[2 * d + 1][1] * inv, 1.f, 2); t = __builtin_amdgcn_cvt_scalef32_pk_fp4_f32(t, a[2 * d + 1][2] * inv, a[2 * d + 1][3] * inv, 1.f, 3); w[d] = t; }
            *(v4u*)(tab + e * F4_REC + uv * 512 + L * 16) = v4u{w[0], w[1], w[2], w[3]};
        }
        if (L == 0) sct[e] = make_float2(sc[0], sc[1]);
    }
}
#define convert_rows_peer convert_rows_fp4
constexpr int PEER_REC = F4_REC;
#else
#define convert_rows_peer convert_rows_fp6
constexpr int PEER_REC = F6_REC;
#endif
constexpr float USCALE = 64.f;
template <bool SRC_BF16>
__device__ __forceinline__ void norm_row(const void* src, bf16* copy_to, const float* gamma, const float* modr, int sh_chunk, int sc_chunk, bf16* orow, int lane) {
    f32x4 v[4]; float ss = 0.f;
#pragma unroll
    for (int j = 0; j < 4; ++j) {
        if constexpr (SRC_BF16) { const u32x2 w = ((const u32x2*)src)[lane + 64 * j]; v[j] = f32x4{bflo(w.x), bfhi(w.x), bflo(w.y), bfhi(w.y)}; }
        else v[j] = ((const f32x4*)src)[lane + 64 * j];
        ss += v[j][0] * v[j][0] + v[j][1] * v[j][1] + v[j][2] * v[j][2] + v[j][3] * v[j][3]; }
    if (copy_to) {
#pragma unroll
        for (int j = 0; j < 4; ++j) { u32x2 w; w.x = pk2(v[j][0], v[j][1]); w.y = pk2(v[j][2], v[j][3]); ((u32x2*)copy_to)[lane + 64 * j] = w;
            v[j] = f32x4{bflo(w.x), bfhi(w.x), bflo(w.y), bfhi(w.y)}; }
        ss = 0.f;
#pragma unroll
        for (int j = 0; j < 4; ++j) ss += v[j][0] * v[j][0] + v[j][1] * v[j][1] + v[j][2] * v[j][2] + v[j][3] * v[j][3]; }
    const float r = rsqrtf(wave_sum(ss) * (1.f / DM_) + EPS_);
#pragma unroll
    for (int j = 0; j < 4; ++j) { const int c = 4 * (lane + 64 * j);
        const f32x4 g = *(const f32x4*)(gamma + c), sc = *(const f32x4*)(modr + sc_chunk * 1024 + c), sh = *(const f32x4*)(modr + sh_chunk * 1024 + c);
        const f32x4 o = v[j] * r * g * (sc + 1.f) + sh;
        u32x2 w; w.x = pk2(o[0], o[1]); w.y = pk2(o[2], o[3]); *(u32x2*)(orow + c) = w; }
}

namespace ml {
typedef short bf16x8 __attribute__((ext_vector_type(8)));
typedef float f32x16 __attribute__((ext_vector_type(16)));
constexpr float KSCALE = 0.08838834764831845f;
constexpr int NCH = 18;
__device__ __forceinline__ int toff(int R, int C) { return R * 256 + ((((C) >> 3) ^ (R & 15)) << 4) + ((C & 7) << 1); }
__device__ __forceinline__ int crow(int reg, int h) { return (reg & 3) + 8 * (reg >> 2) + 4 * h; }
__device__ __forceinline__ unsigned cvtpk(float lo, float hi) { typedef float f2 __attribute__((ext_vector_type(2))); typedef __bf16 b2 __attribute__((ext_vector_type(2))); f2 v = {lo, hi}; b2 b = __builtin_convertvector(v, b2); return __builtin_bit_cast(unsigned, b); }
__device__ __forceinline__ bf16x8 pack8(float a0, float a1, float a2, float a3, float a4, float a5, float a6, float a7) {
    v4u w; w.x = cvtpk(a0, a1); w.y = cvtpk(a2, a3); w.z = cvtpk(a4, a5); w.w = cvtpk(a6, a7); return __builtin_bit_cast(bf16x8, w); }
__device__ __forceinline__ int chunk_tok(int c, int j, int dir) { return seqmap(128 * c + j, dir); }

__device__ __forceinline__ void gate_tables(LAS float* tab, const bf16* projb, const float* gb, int h, int dir, int c, int tid) {
    if (tid < 128) { const bf16* pr = projb + (size_t)chunk_tok(c, tid, dir) * PW + PC_GM + dir * 8 + h;
        tab[256 + tid] = bf2f(pr[0]) + gb[dir * 8 + h]; tab[tid] = log_sigmoid(bf2f(pr[4]) + gb[dir * 8 + 4 + h]); }
    float sc = 0.f;
    if (tid < 128) { sc = tab[tid]; const int ln = tid & 63;
#pragma unroll
        for (int o = 1; o < 64; o <<= 1) { const float up = __shfl_up(sc, o); if (ln >= o) sc += up; }
        if (tid == 63) tab[1023] = sc; }
    __syncthreads();
    if (tid < 128) tab[128 + tid] = sc + (tid >= 64 ? tab[1023] : 0.f);
    __syncthreads();
}
__device__ __forceinline__ void stage_T(LAS unsigned char* T, const bf16* src  , int c, int dir, const LAS float* scale, int lane, int wave) {
#pragma unroll
    for (int it = 0; it < 4; ++it) { const int s = lane + 64 * (it & 1), cc = wave + 8 * (it >> 1);
        const v4u v = *(const v4u*)(src + (size_t)chunk_tok(c, s, dir) * PW + cc * 8);
        const unsigned wd[4] = {v.x, v.y, v.z, v.w};
        if (scale) { const float w = scale[s];
#pragma unroll
            for (int i = 0; i < 4; ++i) { const unsigned p = cvtpk(bflo(wd[i]) * w, bfhi(wd[i]) * w);
                *(LAS unsigned short*)(T + toff(cc * 8 + 2 * i, s)) = (unsigned short)(p & 0xffffu); *(LAS unsigned short*)(T + toff(cc * 8 + 2 * i + 1, s)) = (unsigned short)(p >> 16); }
        } else {
#pragma unroll
            for (int i = 0; i < 4; ++i) { *(LAS unsigned short*)(T + toff(cc * 8 + 2 * i, s)) = (unsigned short)(wd[i] & 0xffffu); *(LAS unsigned short*)(T + toff(cc * 8 + 2 * i + 1, s)) = (unsigned short)(wd[i] >> 16); }
        } }
}
__device__ __forceinline__ void stage_N(LAS unsigned char* T, const bf16* src, int c, int dir, const LAS float* scale, int tid) {
#pragma unroll
    for (int it = 0; it < 4; ++it) { const int id = tid + 512 * it, row = id >> 4, ch = id & 15;
        v4u v = *(const v4u*)(src + (size_t)chunk_tok(c, row, dir) * PW + ch * 8);
        if (scale) { const float w = scale[row]; v.x = cvtpk(bflo(v.x) * w, bfhi(v.x) * w); v.y = cvtpk(bflo(v.y) * w, bfhi(v.y) * w); v.z = cvtpk(bflo(v.z) * w, bfhi(v.z) * w); v.w = cvtpk(bflo(v.w) * w, bfhi(v.w) * w); }
        *(LAS v4u*)(T + toff(row, ch * 8)) = v; }
}

__device__ __forceinline__ void m1_unit(LAS unsigned char* L, const bf16* projb, const float* gb, int h, int dir, int c, bf16* Uout, float* nout, float* Bout) {
    int tid = threadIdx.x; asm volatile("" : "+v"(tid)); const int lane = tid & 63, wave = __builtin_amdgcn_readfirstlane(tid >> 6), r = lane & 31, hh = lane >> 5;
    LAS unsigned char* TV = L; LAS unsigned char* TK = L + 32768; LAS float* tab = (LAS float*)(L + 65536);
    gate_tables(tab, projb, gb, h, dir, c, tid);
    if (tid < 128) tab[384 + tid] = KSCALE * __expf(fminf(tab[128 + 127] - tab[128 + tid] + tab[256 + tid], 80.f));
    __syncthreads();
    stage_T(TV, projb + PC_VM + h * 128, c, dir, tab + 384, lane, wave);
    stage_T(TK, projb + PC_KM + h * 128, c, dir, nullptr, lane, wave);
    __syncthreads();
    const int vt = wave >> 1, dt0 = (wave & 1) * 2;
    f32x16 acc0 = {}, acc1 = {};
#pragma unroll
    for (int ks = 0; ks < 8; ++ks) {
        const bf16x8 a = *(const LAS bf16x8*)(TV + toff(32 * vt + r, 16 * ks + 8 * hh));
        const bf16x8 b0 = *(const LAS bf16x8*)(TK + toff(32 * dt0 + r, 16 * ks + 8 * hh)), b1 = *(const LAS bf16x8*)(TK + toff(32 * dt0 + 32 + r, 16 * ks + 8 * hh));
        acc0 = __builtin_amdgcn_mfma_f32_32x32x16_bf16(a, b0, acc0, 0, 0, 0); acc1 = __builtin_amdgcn_mfma_f32_32x32x16_bf16(a, b1, acc1, 0, 0, 0);
    }
#pragma unroll
    for (int reg = 0; reg < 16; reg += 2) { const int v = 32 * vt + crow(reg, hh); const unsigned w0 = cvtpk(acc0[reg], acc0[reg + 1]), w1 = cvtpk(acc1[reg], acc1[reg + 1]);
        unsigned short* up = (unsigned short*)Uout + v * 128 + 32 * dt0 + r;
        up[0] = (unsigned short)(w0 & 0xffffu); up[128] = (unsigned short)(w0 >> 16); up[32] = (unsigned short)(w1 & 0xffffu); up[160] = (unsigned short)(w1 >> 16); }
    {   const int d = tid & 127, part = tid >> 7; float a = 0.f;
#pragma unroll
        for (int j = 0; j < 4; ++j) { const int s0 = part * 32 + 8 * j; const v4u k8 = *(const LAS v4u*)(TK + toff(d, s0)); const LAS float* w = tab + 384 + s0;
            a += bflo(k8.x) * w[0] + bfhi(k8.x) * w[1] + bflo(k8.y) * w[2] + bfhi(k8.y) * w[3] + bflo(k8.z) * w[4] + bfhi(k8.z) * w[5] + bflo(k8.w) * w[6] + bfhi(k8.w) * w[7]; }
        tab[512 + part * 128 + d] = a; }
    __syncthreads();
    if (tid < 128) nout[tid] = (tab[512 + tid] + tab[640 + tid]) + (tab[768 + tid] + tab[896 + tid]);
    if (tid == 0) Bout[0] = tab[128 + 127];
    __syncthreads();
}

__device__ __forceinline__ void m3_dir(LAS unsigned char* L, const bf16* projb, const float* gb, int h, int dir, int c, const bf16* Udir  , const float* ndir  , const float* Bdir  , f32x16 (&hout)[2]) {
    int tid = threadIdx.x; asm volatile("" : "+v"(tid)); const int lane = tid & 63, wave = __builtin_amdgcn_readfirstlane(tid >> 6), r = lane & 31, hh = lane >> 5;
    LAS unsigned char* TQ = L; LAS unsigned char* TK = L + 32768; LAS unsigned char* TVT = L + 65536; LAS unsigned char* TC = L + 98304;
    LAS float* tab = (LAS float*)(L + 131072 + 1024);
    gate_tables(tab, projb, gb, h, dir, c, tid);
    if (tid < 128) { tab[384 + tid] = __expf(tab[128 + tid]); tab[512 + tid] = KSCALE * __expf(fminf(tab[256 + tid] - tab[128 + tid], 80.f)); }
    {
        float cs[32]; float ns = 0.f;
#pragma unroll
        for (int i = 0; i < 32; ++i) cs[i] = 0.f;
#pragma unroll 4
        for (int cp = 0; cp < c; ++cp) {
            const float dec = __expf(Bdir[cp]);
            const v4u* up = (const v4u*)(Udir + (size_t)cp * 16384 + tid * 32);
            const v4u u0 = up[0], u1 = up[1], u2 = up[2], u3 = up[3];
            const unsigned wd[16] = {u0.x, u0.y, u0.z, u0.w, u1.x, u1.y, u1.z, u1.w, u2.x, u2.y, u2.z, u2.w, u3.x, u3.y, u3.z, u3.w};
#pragma unroll
            for (int i = 0; i < 16; ++i) { cs[2 * i] = cs[2 * i] * dec + bflo(wd[i]); cs[2 * i + 1] = cs[2 * i + 1] * dec + bfhi(wd[i]); }
            if (tid < 128) ns = ns * dec + ndir[cp * 128 + tid];
        }
        const int v = tid >> 2, d0 = (tid & 3) * 32;
#pragma unroll
        for (int q = 0; q < 4; ++q) { v4u w; w.x = cvtpk(cs[8 * q], cs[8 * q + 1]); w.y = cvtpk(cs[8 * q + 2], cs[8 * q + 3]); w.z = cvtpk(cs[8 * q + 4], cs[8 * q + 5]); w.w = cvtpk(cs[8 * q + 6], cs[8 * q + 7]);
            *(LAS v4u*)(TC + toff(v, d0 + 8 * q)) = w; }
        if (tid < 128) tab[640 + tid] = ns;
    }
    __syncthreads();
    stage_N(TQ, projb + PC_QM + h * 128, c, dir, tab + 384, tid);
    stage_N(TK, projb + PC_KM + h * 128, c, dir, nullptr, tid);
    stage_T(TVT, projb + PC_VM + h * 128, c, dir, nullptr, lane, wave);
    __syncthreads();
    const int jt = wave & 3, vh = wave >> 2;
    bf16x8 qf[8];
#pragma unroll
    for (int ks = 0; ks < 8; ++ks) qf[ks] = *(const LAS bf16x8*)(TQ + toff(32 * jt + r, 16 * ks + 8 * hh));
    f32x16 num0 = {}, num1 = {}; float dsum = 0.f;
    const int jpos = 32 * jt + r;
    for (int st = 0; st <= jt; ++st) {
        f32x16 acc = {};
#pragma unroll
        for (int ks = 0; ks < 8; ++ks) { const bf16x8 kf = *(const LAS bf16x8*)(TK + toff(32 * st + r, 16 * ks + 8 * hh)); acc = __builtin_amdgcn_mfma_f32_32x32x16_bf16(kf, qf[ks], acc, 0, 0, 0); }
#pragma unroll
        for (int reg = 0; reg < 16; ++reg) { const int s = 32 * st + crow(reg, hh); float v = acc[reg] * tab[512 + s]; if (s > jpos) v = 0.f; acc[reg] = v; dsum += v; }
#pragma unroll
        for (int k2 = 0; k2 < 2; ++k2) {
            const bf16x8 pf = pack8(acc[8 * k2], acc[8 * k2 + 1], acc[8 * k2 + 2], acc[8 * k2 + 3], acc[8 * k2 + 4], acc[8 * k2 + 5], acc[8 * k2 + 6], acc[8 * k2 + 7]);
            const int g = 2 * st + k2;
#pragma unroll
            for (int t = 0; t < 2; ++t) { const int vr = 32 * (2 * vh + t) + r;
                const u32x2 lo = *(const LAS u32x2*)(TVT + vr * 256 + (((2 * g) ^ (vr & 15)) << 4) + 8 * hh), hi = *(const LAS u32x2*)(TVT + vr * 256 + (((2 * g + 1) ^ (vr & 15)) << 4) + 8 * hh);
                v4u bw; bw.x = lo.x; bw.y = lo.y; bw.z = hi.x; bw.w = hi.y; const bf16x8 bfv = __builtin_bit_cast(bf16x8, bw);
                if (t == 0) num0 = __builtin_amdgcn_mfma_f32_32x32x16_bf16(pf, bfv, num0, 0, 0, 0); else num1 = __builtin_amdgcn_mfma_f32_32x32x16_bf16(pf, bfv, num1, 0, 0, 0); }
        }
    }
#pragma unroll
    for (int ks = 0; ks < 8; ++ks) {
        const bf16x8 c0 = *(const LAS bf16x8*)(TC + toff(32 * (2 * vh) + r, 16 * ks + 8 * hh)), c1 = *(const LAS bf16x8*)(TC + toff(32 * (2 * vh + 1) + r, 16 * ks + 8 * hh));
        num0 = __builtin_amdgcn_mfma_f32_32x32x16_bf16(qf[ks], c0, num0, 0, 0, 0); num1 = __builtin_amdgcn_mfma_f32_32x32x16_bf16(qf[ks], c1, num1, 0, 0, 0);
    }
    float qn = 0.f;
#pragma unroll
    for (int ch = 0; ch < 8; ++ch) { const v4u q8 = *(const LAS v4u*)(TQ + toff(jpos, 64 * hh + 8 * ch)); const LAS float* np = tab + 640 + 64 * hh + 8 * ch;
        qn += bflo(q8.x) * np[0] + bfhi(q8.x) * np[1] + bflo(q8.y) * np[2] + bfhi(q8.y) * np[3] + bflo(q8.z) * np[4] + bfhi(q8.z) * np[5] + bflo(q8.w) * np[6] + bfhi(q8.w) * np[7]; }
    float den = dsum + qn; den += __shfl_xor(den, 32);
    LAS float* dt = tab + 768 + wave * 32;
    if (hh == 0) dt[r] = den;
    LDS_WAIT(); asm volatile("" ::: "memory");
#pragma unroll
    for (int reg = 0; reg < 16; ++reg) { const float sc = __builtin_amdgcn_rcpf(fmaxf(fabsf(dt[crow(reg, hh)]), 1.f)); hout[0][reg] = num0[reg] * sc; hout[1][reg] = num1[reg] * sc; }
    __syncthreads();
}

__device__ __forceinline__ void m3_unit(LAS unsigned char* L, bf16* projb, const float* gb, const float* ng  , int h, int jc, const bf16* Ubh  , const float* nbh  , const float* Bbh  ) {
    f32x16 hf[2], hb[2];
    m3_dir(L, projb, gb, h, 0, jc, Ubh, nbh, Bbh, hf);
    const int cb = jc < 2 ? 1 - jc : 19 - jc;
    m3_dir(L, projb, gb, h, 1, cb, Ubh + (size_t)NCH * 16384, nbh + NCH * 128, Bbh + NCH, hb);
    int tid = threadIdx.x; asm volatile("" : "+v"(tid)); const int lane = tid & 63, wave = __builtin_amdgcn_readfirstlane(tid >> 6), r = lane & 31, hh = lane >> 5, jt = wave & 3, vh = wave >> 2;
    LAS float* hs = (LAS float*)L;
#pragma unroll
    for (int t = 0; t < 2; ++t)
#pragma unroll
        for (int reg = 0; reg < 16; ++reg) hs[(32 * jt + crow(reg, hh)) * 128 + 32 * (2 * vh + t) + r] = hf[t][reg];
    __syncthreads();
#pragma unroll
    for (int t = 0; t < 2; ++t)
#pragma unroll
        for (int reg = 0; reg < 16; ++reg) hs[(127 - (32 * jt + crow(reg, hh))) * 128 + 32 * (2 * vh + t) + r] += hb[t][reg];
    __syncthreads();
    {   const int row = tid >> 2, q = tid & 3; const LAS f32x4* hp = (const LAS f32x4*)(hs + row * 128 + q * 32);
        f32x4 x[8]; float ss = 0.f;
#pragma unroll
        for (int i = 0; i < 8; ++i) { x[i] = hp[i]; ss += x[i][0] * x[i][0] + x[i][1] * x[i][1] + x[i][2] * x[i][2] + x[i][3] * x[i][3]; }
        ss += __shfl_xor(ss, 1); ss += __shfl_xor(ss, 2);
        const float rs = rsqrtf(ss * (1.f / 128.f) + EPS_);
        bf16* pr = projb + (size_t)(128 * jc + row) * PW;
#pragma unroll
        for (int i = 0; i < 4; ++i) { const v4u ov = *(const v4u*)(pr + PC_OM + h * 128 + q * 32 + 8 * i); const f32x4 g0 = *(const f32x4*)(ng + q * 32 + 8 * i), g1 = *(const f32x4*)(ng + q * 32 + 8 * i + 4);
            const f32x4 a = x[2 * i] * rs * g0, b = x[2 * i + 1] * rs * g1;
            v4u w; w.x = cvtpk(a[0] * sigm(bflo(ov.x)), a[1] * sigm(bfhi(ov.x))); w.y = cvtpk(a[2] * sigm(bflo(ov.y)), a[3] * sigm(bfhi(ov.y)));
            w.z = cvtpk(b[0] * sigm(bflo(ov.z)), b[1] * sigm(bfhi(ov.z))); w.w = cvtpk(b[2] * sigm(bflo(ov.w)), b[3] * sigm(bfhi(ov.w)));
            *(v4u*)(pr + PC_QM + h * 128 + q * 32 + 8 * i) = w; }
    }
    __syncthreads();
}
}

namespace s5 {
typedef short bf16x8 __attribute__((ext_vector_type(8)));
typedef float f32x16 __attribute__((ext_vector_type(16)));
__device__ __forceinline__ unsigned cvtpk(float lo, float hi) { typedef float f2 __attribute__((ext_vector_type(2))); typedef __bf16 b2 __attribute__((ext_vector_type(2))); f2 v = {lo, hi}; b2 b = __builtin_convertvector(v, b2); return __builtin_bit_cast(unsigned, b); }
__device__ __forceinline__ float lo_half(float x) { const int l = (int)__builtin_amdgcn_mbcnt_hi(~0u, __builtin_amdgcn_mbcnt_lo(~0u, 0u)); return __shfl(x, l & 31); }
__device__ __forceinline__ float hi_half(float x) { const int l = (int)__builtin_amdgcn_mbcnt_hi(~0u, __builtin_amdgcn_mbcnt_lo(~0u, 0u)); return __shfl(x, (l & 31) + 32); }
__device__ __forceinline__ float other_half(float x) { const int l = (int)__builtin_amdgcn_mbcnt_hi(~0u, __builtin_amdgcn_mbcnt_lo(~0u, 0u)); return __shfl(x, l ^ 32); }
struct cpx { float re, im; };
__device__ __forceinline__ cpx cmul(cpx a, cpx b) { return {a.re * b.re - a.im * b.im, a.re * b.im + a.im * b.re}; }
__device__ __forceinline__ cpx cfma(cpx a, cpx b, cpx c) { float re = __builtin_fmaf(-a.im, b.im, __builtin_fmaf(a.re, b.re, c.re)), im = __builtin_fmaf(a.im, b.re, __builtin_fmaf(a.re, b.im, c.im));
#ifndef S5_ALLOW_PK
    asm("" : "+v"(re));
#endif
    return {re, im}; }

template <bool OUT>
__device__ __forceinline__ void run_blocks(LAS unsigned char* T, const bf16* pb, int dir, bf16* yout, int blk0, int nblk, cpx& S1, cpx& S2,
                                           const cpx (&ap1)[4], const cpx (&ap2)[4], const bf16x8 (&wf)[4], const LAS unsigned char* CF, int lane) {
    const int r = lane & 31, h = lane >> 5;
    v4u unext = *(const v4u*)(pb + (size_t)seqmap(32 * blk0 + r, dir) * PW + 8 * h);
    for (int blk = blk0; blk < blk0 + nblk; ++blk) {
        const bf16x8 uf = __builtin_bit_cast(bf16x8, unext);
        if (blk + 1 < blk0 + nblk) unext = *(const v4u*)(pb + (size_t)seqmap(32 * (blk + 1) + r, dir) * PW + 8 * h);
        const f32x16 z = {};
        f32x16 r1, i1, r2, i2; (void)z;
        asm volatile("v_mfma_f32_32x32x16_bf16 %0, %1, %2, 0" : "=&v"(r1) : "v"(uf), "v"(wf[0]));
        asm volatile("v_mfma_f32_32x32x16_bf16 %0, %1, %2, 0" : "=&v"(i1) : "v"(uf), "v"(wf[1]));
        asm volatile("v_mfma_f32_32x32x16_bf16 %0, %1, %2, 0" : "=&v"(r2) : "v"(uf), "v"(wf[2]));
        asm volatile("v_mfma_f32_32x32x16_bf16 %0, %1, %2, 0" : "=&v"(i2) : "v"(uf), "v"(wf[3]));
        asm volatile("s_nop 15\n\ts_nop 3" : "+v"(r1), "+v"(i1), "+v"(r2), "+v"(i2));
#pragma unroll
        for (int q = 0; q < 4; ++q)
#pragma unroll
            for (int i = 1; i < 4; ++i) { const int g = 4 * q + i;
                const cpx p1 = {r1[g - 1], i1[g - 1]}, p2 = {r2[g - 1], i2[g - 1]};
                const cpx n1 = cfma(ap1[0], p1, {r1[g], i1[g]}), n2 = cfma(ap2[0], p2, {r2[g], i2[g]});
                r1[g] = n1.re; i1[g] = n1.im; r2[g] = n2.re; i2[g] = n2.im; }
        cpx cin1[4], cin2[4];
        cpx e1[4], e2[4], o1[4], o2[4];
#pragma unroll
        for (int q = 0; q < 4; ++q) { e1[q] = {r1[4 * q + 3], i1[4 * q + 3]}; e2[q] = {r2[4 * q + 3], i2[4 * q + 3]}; }
#pragma unroll
        for (int q = 0; q < 4; ++q) { o1[q] = {other_half(e1[q].re), other_half(e1[q].im)}; o2[q] = {other_half(e2[q].re), other_half(e2[q].im)}; }
        cpx P1 = S1, P2 = S2;
#pragma unroll
        for (int q = 0; q < 4; ++q) {
            const cpx fe1 = h ? o1[q] : e1[q], fo1 = h ? e1[q] : o1[q], fe2 = h ? o2[q] : e2[q], fo2 = h ? e2[q] : o2[q];
            const cpx ce1 = P1, ce2 = P2;
            P1 = cfma(ap1[3], P1, fe1); P2 = cfma(ap2[3], P2, fe2);
            const cpx co1 = P1, co2 = P2;
            P1 = cfma(ap1[3], P1, fo1); P2 = cfma(ap2[3], P2, fo2);
            cin1[q] = h ? co1 : ce1; cin2[q] = h ? co2 : ce2;
        }
        S1 = P1; S2 = P2;
        if constexpr (OUT) {
#pragma unroll
            for (int q = 0; q < 4; ++q)
#pragma unroll
                for (int i = 0; i < 4; ++i) { const int g = 4 * q + i, t = 8 * q + 4 * h + i;
                    const cpx s1 = cfma(ap1[i], cin1[q], {r1[g], i1[g]}), s2 = cfma(ap2[i], cin2[q], {r2[g], i2[g]});
                    u32x2 w; w.x = cvtpk(s1.re, s1.im); w.y = cvtpk(s2.re, s2.im);
                    *(LAS u32x2*)(T + t * 256 + ((((r >> 1) ^ (t & 15))) << 4) + (r & 1) * 8) = w; }
            LDS_WAIT(); asm volatile("" ::: "memory"); SHIFT_AT(53);
            f32x16 y = {};
#pragma unroll
            for (int ks = 0; ks < 8; ++ks) { const bf16x8 af = *(const LAS bf16x8*)(T + r * 256 + (((2 * ks + h) ^ (r & 15)) << 4)); const bf16x8 cfv = *(const LAS bf16x8*)(CF + (ks * 64 + lane) * 16); y = __builtin_amdgcn_mfma_f32_32x32x16_bf16(af, cfv, y, 0, 0, 0); asm volatile("" :: "v"(af), "v"(cfv)); }
            LDS_WAIT(); asm volatile("" ::: "memory"); SHIFT_AT(54);
            if (r < 16) {
#pragma unroll
                for (int reg = 0; reg < 16; reg += 2) { const int t = (reg & 3) + 8 * (reg >> 2) + 4 * h; const unsigned w = cvtpk(y[reg], y[reg + 1]);
                    *(LAS unsigned short*)(T + t * 32 + r * 2) = (unsigned short)(w & 0xffffu); *(LAS unsigned short*)(T + (t + 1) * 32 + r * 2) = (unsigned short)(w >> 16); } }
            LDS_WAIT(); asm volatile("" ::: "memory");
            { const int t = lane >> 1, hf = lane & 1; const v4u ov = *(const LAS v4u*)(T + t * 32 + hf * 16);
              *(v4u*)(yout + (size_t)seqmap(32 * blk + t, dir) * 512 + hf * 8) = ov; }
            LDS_WAIT(); asm volatile("" ::: "memory");
        }
    }
}
__device__ __forceinline__ void chain4(LAS unsigned char* lds, const bf16* pb, const float2* a_tab, const float2* bb_tab, const v4u* cft, int dir, bf16* yout, int seg, int chain_slot) {
    int lane = threadIdx.x & 63; asm volatile("" : "+v"(lane)); const int r = lane & 31, h = lane >> 5;
    const int wv = chain_slot * 4 + seg;
    LAS unsigned char* T = lds + wv * 8192;
    LAS float* EX = (LAS float*)(lds + 65536) + chain_slot * 4 * 128;
    cpx ap1[4], ap2[4];
    { const float2 a1 = a_tab[r], a2 = a_tab[32 + r]; ap1[0] = {a1.x, a1.y}; ap2[0] = {a2.x, a2.y};
#pragma unroll
      for (int k = 1; k < 4; ++k) { ap1[k] = cmul(ap1[k - 1], ap1[0]); ap2[k] = cmul(ap2[k - 1], ap2[0]); } }
    bf16x8 wf[4];
#pragma unroll
    for (int gi = 0; gi < 4; ++gi) { const float2* bp = bb_tab + (size_t)((gi >> 1) * 32 + r) * 16 + 8 * h; float v[8];
#pragma unroll
        for (int j = 0; j < 8; ++j) v[j] = (gi & 1) ? bp[j].y : bp[j].x;
        v4u w; w.x = cvtpk(v[0], v[1]); w.y = cvtpk(v[2], v[3]); w.z = cvtpk(v[4], v[5]); w.w = cvtpk(v[6], v[7]); wf[gi] = __builtin_bit_cast(bf16x8, w); }
    constexpr int NBS = SB / 32 / 4;
    cpx S1 = {0.f, 0.f}, S2 = {0.f, 0.f};
    LAS unsigned char* CF = lds + 65536 + 4096 + chain_slot * 8192;
    SHIFT_AT(33);
    if (seg == 3) {
        v4u w[8];
#pragma unroll
        for (int ks = 0; ks < 8; ++ks) w[ks] = cft[ks * 32 + h * 16 + (r & 15)];
#pragma unroll
        for (int ks = 0; ks < 8; ++ks) { v4u o = w[ks]; if (r >= 16) o = v4u{0u, 0u, 0u, 0u}; *(LAS v4u*)(CF + (ks * 64 + lane) * 16) = o; }
    } else run_blocks<false>(T, pb, dir, yout, seg * NBS, NBS, S1, S2, ap1, ap2, wf, CF, lane);
    if (h == 0) { LAS float* e = EX + (seg * 32 + r) * 4; e[0] = S1.re; e[1] = S1.im; e[2] = S2.re; e[3] = S2.im; }
    __syncthreads(); SHIFT_AT(34);
    cpx p1 = ap1[3], p2 = ap2[3];
#pragma unroll
    for (int k = 0; k < 4; ++k) { p1 = cmul(p1, p1); p2 = cmul(p2, p2); }
    cpx q1 = p1, q2 = p2;
#pragma unroll
    for (int k = 0; k < 3; ++k) { q1 = cmul(q1, q1); q2 = cmul(q2, q2); }
    const cpx A1 = cmul(q1, p1), A2 = cmul(q2, p2);
    S1 = {0.f, 0.f}; S2 = {0.f, 0.f};
    for (int j = 0; j < seg; ++j) { const LAS float* e = EX + (j * 32 + r) * 4; S1 = cfma(A1, S1, {e[0], e[1]}); S2 = cfma(A2, S2, {e[2], e[3]}); }
    SHIFT_AT(35);
    run_blocks<true>(T, pb, dir, yout, seg * NBS, NBS, S1, S2, ap1, ap2, wf, CF, lane);
    SHIFT_AT(36);
    __syncthreads();
}
}

__global__ void __launch_bounds__(NWAVES * 64, 2) mk_fwd(Args args) {
    extern __shared__ __attribute__((aligned(16))) unsigned char lds[];
    struct { LAS unsigned char* lds; } F; F.lds = (LAS unsigned char*)lds;
    const int G = gridDim.x; int vcu; { const int bx = blockIdx.x; vcu = (G % 8 == 0) ? (bx % 8) * (G / 8) + bx / 8 : bx; }
    const int NGW = G * NWAVES; const size_t NTHR = (size_t)G * 512;
    volatile LAS unsigned* MISC = (volatile LAS unsigned*)(F.lds + MISC_OFF);
    for (int u = threadIdx.x; u < (LDS_BYTES - LDSCTL_OFF) / 4; u += NWAVES * 64) ((LAS unsigned*)(F.lds + LDSCTL_OFF))[u] = 0u;
#define PH_IDS int tid = threadIdx.x; asm volatile("" : "+v"(tid)); const int lane = tid & 63; const int wave = __builtin_amdgcn_readfirstlane(tid >> 6); \
    const int gw = vcu * NWAVES + wave; const size_t gtid = (size_t)vcu * 512 + tid; (void)lane; (void)gw; (void)gtid; PH_PTRS
    __syncthreads();
    XcdBarrier bar = xcd_barrier_post((unsigned*)(args.ws + WS_CTL) + CW_BAR, MISC + 8);
    (void)bar;
#define GRID_BAR() do { KArgsP B_ = (KArgsP)__builtin_amdgcn_kernarg_segment_ptr(); asm volatile("" : "+s"(B_)); XcdBarrier b_; b_.bar = (unsigned*)(B_->ws + WS_CTL) + CW_BAR; b_.x = xb_xcc_id(); \
    b_.st = (volatile LAS unsigned*)((LAS unsigned char*)lds + MISC_OFF) + 8; xcd_barrier(b_); if (DOUBLE_BAR) xcd_barrier(b_); } while (0)
#ifndef TIMING_UNIT
#define TIMING_UNIT 1e-4f
#endif
#ifdef TIMING_MASK
#define STAMP(pid) do { if (blockIdx.x == 0 && threadIdx.x == 0) { volatile LAS unsigned long long* tq = (volatile LAS unsigned long long*)((LAS unsigned char*)lds + LDSCTL_OFF + 64); \
        const unsigned long long now = __builtin_amdgcn_s_memrealtime(); tq[1 + (pid)] += now - tq[0]; tq[0] = now; } } while (0)
#else
#define STAMP(pid) do {} while (0)
#endif
    STAMP(15);

#define PH_PTRS KArgsP A_ = (KArgsP)__builtin_amdgcn_kernarg_segment_ptr(); asm volatile("" : "+s"(A_)); unsigned char* ws = A_->ws; \
    const float* x = A_->in[0]; const float* cvec = A_->in[1]; const float* ctx = A_->in[2]; const float* cctx = A_->in[3]; \
    const float* w_mod = A_->in[4]; const float* b_mod = A_->in[5]; const float* norm1_g = A_->in[6]; const float* norm2_g = A_->in[7]; const float* w_in = A_->in[8]; \
    const float* lam_re = A_->in[9]; const float* lam_im = A_->in[10]; const float* log_step = A_->in[11]; \
    const float* sb_re = A_->in[12]; const float* sb_im = A_->in[13]; const float* sc_re = A_->in[14]; const float* sc_im = A_->in[15]; \
    const float* ssm_d = A_->in[16]; const float* w_glu = A_->in[17]; const float* qng = A_->in[18]; const float* kng = A_->in[19]; \
    const float* gate_b = A_->in[20]; const float* ml_ng = A_->in[21]; \
    const float* w_br[3] = {A_->in[22], A_->in[23], A_->in[24]}; const float* w_out = A_->in[25]; \
    const float* w_q = A_->in[26]; const float* sk1 = A_->in[27]; const float* sk2 = A_->in[28]; \
    const float* pu = A_->in[29]; const float* pv = A_->in[30]; const float* fng = A_->in[31]; \
    float* out = A_->out; \
    float* mod = (float*)(ws + WS_MOD); float2* s5a = (float2*)(ws + WS_S5A); float2* s5bb = (float2*)(ws + WS_S5B); float2* ropet = (float2*)(ws + WS_ROPE); \
    bf16* Win_t = (bf16*)(ws + WS_WIN); bf16* Wglu_t = (bf16*)(ws + WS_WGLU); bf16* Wbr_t = (bf16*)(ws + WS_WBR); bf16* Wout_t = (bf16*)(ws + WS_WOUT); bf16* Wq_t = (bf16*)(ws + WS_WQ); \
    unsigned char* Utab0 = ws + WS_TAB;   \
    bf16* strm = (bf16*)(ws + WS_STRM); bf16* hA = (bf16*)(ws + WS_HA); bf16* ydir = (bf16*)(ws + WS_YDIR); bf16* proj = (bf16*)(ws + WS_PROJ); \
    float* scores = (float*)(ws + WS_SC); int* eidx = (int*)(ws + WS_EIDX); float* gates = (float*)(ws + WS_GATE); float* mln = (float*)(ws + WS_MLN); float* mlb = (float*)(ws + WS_MLB); v4u* s5cf = (v4u*)(ws + WS_S5CF); float2* sct = (float2*)(ws + WS_SCT);
    {
        {   PH_IDS
        if (vcu < 192) {
            const int l = vcu / 96, j0 = (vcu % 96) * 64;
            LAS float* sl = (LAS float*)F.lds;
            LAS float* red = sl + 9 * 1024;
            for (int i = tid; i < 9 * 1024; i += 512) { const int r = i >> 10, k = i & 1023; const float v = r < 8 ? cvec[r * 1024 + k] : cctx[k]; sl[i] = v / (1.f + expf(-v)); }
            __syncthreads();
            const int jl = tid & 63, kq = tid >> 6;
            float acc[9];
#pragma unroll
            for (int r = 0; r < 9; ++r) acc[r] = 0.f;
            const float* wp = w_mod + (size_t)l * 1024 * 6144 + j0 + jl;
#pragma unroll 16
            for (int k = kq * 128; k < kq * 128 + 128; ++k) { const float w = wp[(size_t)k * 6144];
#pragma unroll
                for (int r = 0; r < 9; ++r) acc[r] += sl[r * 1024 + k] * w; }
#pragma unroll
            for (int r = 0; r < 9; ++r) red[(kq * 9 + r) * 64 + jl] = acc[r];
            __syncthreads();
            for (int i = tid; i < 576; i += 512) { const int r = i >> 6, j = i & 63; float s = 0.f;
#pragma unroll
                for (int q = 0; q < 8; ++q) s += red[(q * 9 + r) * 64 + j];
                mod[(l * 9 + r) * 6144 + j0 + j] = s + b_mod[l * 6144 + j0 + j]; }
            __syncthreads();
        }
        for (int it = vcu; it < 256; it += G) {
            const int l = it >> 7, hh = (it >> 3) & 15, k0 = (it & 7) * 128;
            LAS float* wqT = (LAS float*)F.lds;
            LAS float* skT = wqT + 128 * 128;
            const float* wsrc = w_q + (size_t)l * 1024 * 2048 + hh * 128;
            const float* ssrc = ((hh & 1) ? sk2 : sk1) + l * 16384;
            {   const int rr = tid & 127, q = tid >> 7;
                const float* wr_ = wsrc + (size_t)(k0 + rr) * 2048 + q * 32; const float* sr_ = ssrc + rr * 128 + q * 32;
#pragma unroll
                for (int c = 0; c < 8; ++c) { const f32x4 a = *(const f32x4*)(wr_ + 4 * c), s4 = *(const f32x4*)(sr_ + 4 * c);
#pragma unroll
                    for (int e = 0; e < 4; ++e) { wqT[(q * 32 + 4 * c + e) * 128 + rr] = a[e]; skT[(q * 32 + 4 * c + e) * 128 + rr] = s4[e]; } } }
            __syncthreads();
            const int kt = tid & 15, keyt = tid >> 4;
            float acc[4][8];
#pragma unroll
            for (int a = 0; a < 4; ++a)
#pragma unroll
                for (int b2 = 0; b2 < 8; ++b2) acc[a][b2] = 0.f;
#pragma unroll 4
            for (int d = 0; d < 128; ++d) { const f32x4 w0 = *(const LAS f32x4*)(wqT + d * 128 + kt * 8), w1 = *(const LAS f32x4*)(wqT + d * 128 + kt * 8 + 4), s4 = *(const LAS f32x4*)(skT + d * 128 + keyt * 4);
#pragma unroll
                for (int a = 0; a < 4; ++a) { acc[a][0] += s4[a] * w0[0]; acc[a][1] += s4[a] * w0[1]; acc[a][2] += s4[a] * w0[2]; acc[a][3] += s4[a] * w0[3];
                    acc[a][4] += s4[a] * w1[0]; acc[a][5] += s4[a] * w1[1]; acc[a][6] += s4[a] * w1[2]; acc[a][7] += s4[a] * w1[3]; } }
#pragma unroll
            for (int a = 0; a < 4; ++a) { v4u o; o.x = pk2(acc[a][0], acc[a][1]); o.y = pk2(acc[a][2], acc[a][3]); o.z = pk2(acc[a][4], acc[a][5]); o.w = pk2(acc[a][6], acc[a][7]);
                *(v4u*)(Wq_t + ((size_t)l * 2048 + hh * 128 + keyt * 4 + a) * 1024 + k0 + kt * 8) = o; }
            __syncthreads();
        }
        {
            LAS float* scr = (LAS float*)(F.lds + wave * 16384);
            constexpr int I_IN = 16 * (PW / 32), I_GLU = 8 * 16, I_BR = 8 * 32, I_OUT = 16 * 32;
            constexpr int PER_L = I_IN + I_GLU + 3 * I_BR + I_OUT;
            for (int it = gw; it < 2 * PER_L; it += NGW) {
                const int l = it / PER_L; int r = it % PER_L;
                if (r < I_IN) { transpose_win(w_in + (size_t)l * DM_ * INW, Win_t + (size_t)l * PW * 1024, r, scr, lane); continue; } r -= I_IN;
                if (r < I_GLU) { transpose_plain(w_glu + (size_t)l * 512 * 512, 512, 512, Wglu_t + (size_t)l * 512 * 512, r, scr, lane); continue; } r -= I_GLU;
                if (r < 3 * I_BR) { const int br = r / I_BR; transpose_plain(w_br[br] + (size_t)l * 512 * 1024, 512, 1024, Wbr_t + ((size_t)l * 3 + br) * 1024 * 512, r % I_BR, scr, lane); continue; } r -= 3 * I_BR;
                transpose_plain(w_out + (size_t)l * 1024 * 1024, 1024, 1024, Wout_t + (size_t)l * 1024 * 1024, r, scr, lane);
            }
        }
        }
        {   PH_IDS
        if (G != 256) {
        convert_rows_peer(pu, pv, Utab0, sct, gtid, NTHR); }
        }
        {   PH_IDS
        for (size_t idx = gtid; idx < 2 * 4096; idx += NTHR) {
            const float step = expf(log_step[idx >> 6]);
            const float lr = lam_re[idx], li = lam_im[idx];
            const float mag = expf(lr * step); const float are = mag * cosf(li * step), aim = mag * sinf(li * step);
            const float den = lr * lr + li * li;
            const float zre = ((are - 1.f) * lr + aim * li) / den, zim = (aim * lr - (are - 1.f) * li) / den;
            s5a[idx] = make_float2(are, aim);
            for (int c = 0; c < 16; ++c) { const float br = sb_re[idx * 16 + c], bi = sb_im[idx * 16 + c]; s5bb[idx * 16 + c] = make_float2(zre * br - zim * bi, zre * bi + zim * br); }
        }
        for (size_t idx = gtid; idx < 128 * 256; idx += NTHR) {
            const int c = (int)idx & 15, h = ((int)idx >> 4) & 1, ks = ((int)idx >> 5) & 7, ci = (int)idx >> 8; float v[8];
#pragma unroll
            for (int j = 0; j < 8; ++j) { const int k = 16 * ks + 8 * h + j, n = 32 * ((k >> 1) & 1) + (k >> 2); v[j] = (k & 1) ? -sc_im[(size_t)ci * 1024 + c * 64 + n] : sc_re[(size_t)ci * 1024 + c * 64 + n]; }
            v4u w; w.x = pk2(v[0], v[1]); w.y = pk2(v[2], v[3]); w.z = pk2(v[4], v[5]); w.w = pk2(v[6], v[7]); s5cf[idx] = w;
        }
        for (size_t idx = gtid; idx < 64 * 16; idx += NTHR) { const int p = (int)idx >> 4, f = (int)idx & 15; const float inv = exp2f(-(float)f * (13.287712379549449f / 16.f)); const float ang = (float)p * inv; ropet[idx] = make_float2(cosf(ang), sinf(ang)); }
        }
    }
    GRID_BAR(); STAMP(0);
    { PH_IDS
    for (int row = gw; row < MROWS; row += NGW) {
        const int b = row / SB, t = row % SB;
        const float* src = t < NCTX ? ctx + ((size_t)b * NCTX + t) * DM_ : x + ((size_t)b * SEQ + (t - NCTX)) * DM_;
        norm_row<false>(src, strm + (size_t)row * DM_, norm1_g, mod + (t < NCTX ? 8 : b) * 6144, 0, 1, hA + (size_t)row * DM_, lane);
    } }
    GRID_BAR(); STAMP(1); SHIFT_HERE();

    for (int l = 0; l < 2; ++l) {
        {   PH_PTRS
            pg8::Gemm g{hA, Win_t + (size_t)l * PW * 1024, MROWS, PW, 1024, 1024, 1024}; G1Order S; S.init(l, G, (int)blockIdx.x);
            pg8::EpiBf16<0> E{proj, PW, nullptr, 0, 0, 1.f};
            pg8::gemm_phase<pg8::EpiBf16<0>, G1Order, true, true>(F.lds, g, S, E);
            if (l == 0 && G == 256 && (int)blockIdx.x >= 80) {
                int tid2 = threadIdx.x; asm volatile("" : "+v"(tid2));
                const size_t gt2 = (size_t)((int)blockIdx.x - 80) * 512 + tid2, nt2 = (size_t)(G - 80) * 512;
                convert_rows_peer(pu, pv, Utab0, sct, gt2, nt2);
            }
        }
        GRID_BAR(); STAMP(2); SHIFT_AT(2);
        { PH_IDS
        const int i0 = 8 * (lane & 7), axis = i0 >> 5, half = (i0 >> 4) & 1, f0 = i0 & 15;
        f32x4 gq0 = *(const f32x4*)(qng + l * 64 + i0), gq1 = *(const f32x4*)(qng + l * 64 + i0 + 4), gk0 = *(const f32x4*)(kng + l * 64 + i0), gk1 = *(const f32x4*)(kng + l * 64 + i0 + 4);
#define P2_APPLY(ptr, rw, t_, G0, G1, SC) do { float x[8] = {bflo(rw.x), bfhi(rw.x), bflo(rw.y), bfhi(rw.y), bflo(rw.z), bfhi(rw.z), bflo(rw.w), bfhi(rw.w)}; \
            float ss = (x[0] * x[0] + x[1] * x[1]) + (x[2] * x[2] + x[3] * x[3]) + (x[4] * x[4] + x[5] * x[5]) + (x[6] * x[6] + x[7] * x[7]); \
            ss += __shfl_xor(ss, 1); ss += __shfl_xor(ss, 2); ss += __shfl_xor(ss, 4); \
            const float rr = rsqrtf(ss * (1.f / 64.f) + EPS_); float o[8]; \
            _Pragma("unroll") for (int j = 0; j < 8; ++j) x[j] *= rr * (j < 4 ? G0[j] : G1[j - 4]); \
            if ((t_) >= NCTX) { const int pos = (t_) - NCTX; const f32x4* cp = (const f32x4*)(ropet + (axis == 0 ? (pos >> 6) : (pos & 63)) * 16 + f0); \
                _Pragma("unroll") for (int q = 0; q < 4; ++q) { const f32x4 c2 = cp[q];            \
                    const float xa = x[2 * q], xb = x[2 * q + 1], pa = __shfl_xor(xa, 2), pb = __shfl_xor(xb, 2); \
                    o[2 * q] = half == 0 ? (xa * c2[0] - pa * c2[1]) : (pa * c2[1] + xa * c2[0]); o[2 * q + 1] = half == 0 ? (xb * c2[2] - pb * c2[3]) : (pb * c2[3] + xb * c2[2]); } \
            } else { _Pragma("unroll") for (int j = 0; j < 8; ++j) o[j] = x[j]; }                     \
            v4u w; w.x = pk2(o[0] * (SC), o[1] * (SC)); w.y = pk2(o[2] * (SC), o[3] * (SC)); w.z = pk2(o[4] * (SC), o[5] * (SC)); w.w = pk2(o[6] * (SC), o[7] * (SC)); *(v4u*)(ptr) = w; } while (0)
        for (int r4 = gw * 4; r4 < MROWS; r4 += NGW * 4) {
            const int t4 = r4 % SB; const bool doq = !(l == 1 && t4 < NCTX);
            bf16* qp = proj + (size_t)r4 * PW + PC_QA + lane * 8; bf16* kp = proj + (size_t)(r4 + (lane >> 4)) * PW + PC_KA + (lane & 15) * 8;
            v4u rq[4] = {}; const v4u rk = *(const v4u*)kp;
            if (doq) {
#pragma unroll
                for (int q = 0; q < 4; ++q) rq[q] = *(const v4u*)(qp + (size_t)q * PW); }
            P2_APPLY(kp, rk, t4 + (lane >> 4), gk0, gk1, 1.f);
            if (doq) {
#pragma unroll
                for (int q = 0; q < 4; ++q) P2_APPLY(qp + (size_t)q * PW, rq[q], t4 + q, gq0, gq1, ATT_C2); }
        }
#undef P2_APPLY
        }
        GRID_BAR(); STAMP(3); SHIFT_AT(3);
        { PH_IDS
#ifndef NO_ATT
        for (int u = vcu; u < (l == 0 ? 576 : 512); u += G) {
            const attn_body::bf16* P = (const attn_body::bf16*)proj;
            if (u < 512) { const int qb = u & 7, hq = (u >> 3) & 7, b = u >> 6; const size_t r0 = (size_t)b * SB;
                const attn_body::bf16* Qu = P + (r0 + NCTX + qb * 256) * PW + PC_QA + hq * 64;
                attn_body::attn_unit<8>(Qu, P + r0 * PW + PC_KA + (hq >> 2) * 64, P + r0 * PW + PC_VA + (hq >> 2) * 64, (attn_body::bf16*)Qu, 36, (char*)lds);
            } else { const int uu = u - 512, hq = uu & 7, b = uu >> 3; const size_t r0 = (size_t)b * SB;
                const attn_body::bf16* Qu = P + r0 * PW + PC_QA + hq * 64;
                attn_body::attn_unit<8>(Qu, P + r0 * PW + PC_KA + (hq >> 2) * 64, P + r0 * PW + PC_VA + (hq >> 2) * 64, (attn_body::bf16*)Qu, 4, (char*)lds);
            }
        }
#endif
        __syncthreads(); SHIFT_AT(31);
#ifndef NO_MLSTM
        for (int k5 = 0; ; ++k5) {
            int un = vcu + k5 * G;
            if (G == 256) { if (k5 == 4) { if (vcu < 64 || vcu >= 192) break; un = 1024 + (vcu - 64); } }
            if (un >= 1152) break;
            const int c = un % 18, dir = (un / 18) & 1, h = (un / 36) & 3, b = un / 144;
            ml::m1_unit(F.lds, proj + (size_t)b * SB * PW, gate_b + l * 16, h, dir, c, hA + (size_t)un * 16384, mln + (size_t)un * 128, mlb + un);
        }
#endif
        asm volatile(".p2align 8\n\t.rept " SHIFT_STR(S5_PIN_NOPS) "\n\ts_nop 0\n\t.endr");
        SHIFT_AT(32);
#ifndef NO_S5
        for (int c0 = vcu * 2; c0 < 512; c0 += 2 * G) {
            const int ch = c0 + (wave >> 2), b = ch >> 6, dir = (ch >> 5) & 1, g = ch & 31; const int ci = (l * 2 + dir) * 32 + g;
            s5::chain4(F.lds, proj + (size_t)b * SB * PW + PC_US + g * 16, s5a + (size_t)ci * 64, s5bb + (size_t)ci * 1024, s5cf + (size_t)ci * 256, dir,
                       ydir + ((size_t)dir * MROWS + (size_t)b * SB) * 512 + g * 16, wave & 3, wave >> 2);
        }
#endif
        }
        GRID_BAR(); STAMP(4); SHIFT_AT(4);
        { PH_IDS
#ifndef NO_MLSTM
        for (int un = vcu; un < (l == 0 ? 576 : 512); un += G) {
            int jc, h, b; if (l == 0) { jc = un % 18; h = (un / 18) & 3; b = un / 72; } else { jc = 2 + (un & 15); h = (un >> 4) & 3; b = un >> 6; }
            const size_t bh = (size_t)(b * 4 + h) * 2 * 18;
            ml::m3_unit(F.lds, proj + (size_t)b * SB * PW, gate_b + l * 16, ml_ng + l * 512 + h * 128, h, jc, hA + bh * 16384, mln + bh * 128, mlb + bh);
        }
#endif
        const bool spare64 = (l == 0 && G == 256);
        for (int row = spare64 ? (vcu - 64) * NWAVES + wave : gw; row < MROWS && row >= 0; row += spare64 ? (G - 64) * NWAVES : NGW) {
            bf16* pr = proj + (size_t)row * PW;
            const int c0 = lane * 8;
            {   const v4u uv = *(const v4u*)(pr + PC_US + c0), y0 = *(const v4u*)(ydir + (size_t)row * 512 + c0), y1 = *(const v4u*)(ydir + ((size_t)MROWS + row) * 512 + c0);
                const float* dk = ssm_d + l * 512 + c0; const f32x4 d0 = *(const f32x4*)dk, d1 = *(const f32x4*)(dk + 4);
                v4u w;
                w.x = pk2(gelu_tanh(d0[0] * bflo(uv.x) + bflo(y0.x) + bflo(y1.x)), gelu_tanh(d0[1] * bfhi(uv.x) + bfhi(y0.x) + bfhi(y1.x)));
                w.y = pk2(gelu_tanh(d0[2] * bflo(uv.y) + bflo(y0.y) + bflo(y1.y)), gelu_tanh(d0[3] * bfhi(uv.y) + bfhi(y0.y) + bfhi(y1.y)));
                w.z = pk2(gelu_tanh(d1[0] * bflo(uv.z) + bflo(y0.z) + bflo(y1.z)), gelu_tanh(d1[1] * bfhi(uv.z) + bfhi(y0.z) + bfhi(y1.z)));
                w.w = pk2(gelu_tanh(d1[2] * bflo(uv.w) + bflo(y0.w) + bflo(y1.w)), gelu_tanh(d1[3] * bfhi(uv.w) + bfhi(y0.w) + bfhi(y1.w)));
                *(v4u*)(pr + PC_US + c0) = w; }
        } }
        GRID_BAR(); STAMP(5); SHIFT_AT(5);
        {   PH_PTRS
            pg8::Gemm g{proj + PC_US, Wglu_t + (size_t)l * 512 * 512, MROWS, 512, 512, PW, 512}; EpiGlu E{proj + PC_US, PW, ydir, 512};
            { RowOrder S; S.init(l, 512, G, (int)blockIdx.x); pg8::gemm_phase<EpiGlu, RowOrder, true, true>(F.lds, g, S, E); }
        }
        {   PH_PTRS
            pg8::Gemm g{proj + PC_QA, Wbr_t + ((size_t)l * 3 + 1) * 1024 * 512, MROWS, 1024, 512, PW, 512}; EpiGate E{proj + PC_GL + 1024, PW, hA, 1024, 0};
            { RowOrder S; S.init(l, 1024, G, (int)blockIdx.x, l == 0 ? 144 : 0); pg8::gemm_phase<EpiGate, RowOrder, true, true>(F.lds, g, S, E); }
        }
        {   PH_PTRS
            pg8::Gemm g{proj + PC_QM, Wbr_t + ((size_t)l * 3 + 2) * 1024 * 512, MROWS, 1024, 512, PW, 512}; EpiGate E{proj + PC_GL + 2048, PW, hA, 1024, 1};
            { RowOrder S; S.init(l, 1024, G, (int)blockIdx.x, l == 0 ? 144 : 0); pg8::gemm_phase<EpiGate, RowOrder, true, true>(F.lds, g, S, E); }
        }
        GRID_BAR(); STAMP(6); SHIFT_AT(6);
        {   PH_PTRS
            pg8::Gemm g{ydir, Wbr_t + ((size_t)l * 3 + 0) * 1024 * 512, MROWS, 1024, 512, 512, 512}; EpiGate E{proj + PC_GL, PW, hA, 1024, 1};
            { RowOrder S; S.init(l, 1024, G, (int)blockIdx.x); pg8::gemm_phase<EpiGate, RowOrder, true, true>(F.lds, g, S, E); }
        }
        GRID_BAR(); STAMP(7); SHIFT_AT(7);
        {   PH_PTRS
            pg8::Gemm g{hA, Wout_t + (size_t)l * 1024 * 1024, MROWS, 1024, 1024, 1024, 1024}; EpiResid E{strm, (mod + l * 9 * 6144), 2};
            { RowOrder S; S.init(l, 1024, G, (int)blockIdx.x); pg8::gemm_phase<EpiResid, RowOrder, true, true>(F.lds, g, S, E); }
            if (l == 0 && G > 32 && (int)blockIdx.x >= 32) {
                int tid2 = threadIdx.x; asm volatile("" : "+v"(tid2));
                const size_t gt2 = (size_t)((int)blockIdx.x - 32) * 512 + tid2, nt2 = (size_t)(G - 32) * 512;
                convert_rows_peer(pu + (size_t)16384 * 1024, pv + (size_t)16384 * 1024, Utab0 + (size_t)16384 * PEER_REC, sct + 16384, gt2, nt2);
            }
        }
        GRID_BAR(); STAMP(8); SHIFT_AT(8);
        { PH_IDS
        for (int row = gw; row < MROWS; row += NGW) {
            const int b = row / SB, t = row % SB;
            if (l == 1 && t < NCTX) continue;
            norm_row<true>(strm + (size_t)row * DM_, nullptr, norm2_g + l * 1024, (mod + l * 9 * 6144) + (t < NCTX ? 8 : b) * 6144, 3, 4, hA + (size_t)row * DM_, lane);
        } }
        GRID_BAR(); STAMP(9); SHIFT_AT(9);
        {   PH_PTRS
            pg8::Gemm g{hA, Wq_t + (size_t)l * 2048 * 1024, MROWS, 2048, 1024, 1024, 1024}; pg8::EpiBf16<0> E{(bf16*)scores, 2048, nullptr, 0, 0, 1.f};
            { RowOrder S; S.init(l, 2048, G, (int)blockIdx.x); pg8::gemm_phase<pg8::EpiBf16<0>, RowOrder, true, true>(F.lds, g, S, E); }
        }
        GRID_BAR(); STAMP(10); SHIFT_AT(10);
        {   PH_IDS
            LAS unsigned* wq = (LAS unsigned*)(F.lds + wave * 8192);
            const int ntask = (l == 0 ? MROWS : NB * SEQ) * 8;
            for (int q0 = gw * 64; q0 < ntask; q0 += NGW * 64) {
                const int q = q0 + lane; int pair;
                if (l == 0) pair = q; else { const int b = q >> 14, rem = q & 16383; pair = (b * SB + NCTX) * 8 + rem; }
                const bool live = q < ntask;
                const bf16* s = (const bf16*)scores + (size_t)(live ? pair : 0) * 256;
                float t1[16], t2[16];
#pragma unroll
                for (int hf = 0; hf < 2; ++hf) {
                    float tv[16];
                    const v4u* sp = (const v4u*)(s + hf * 128);
#define CEX(a, b) do { const float hi_ = fmaxf(a, b), lo_ = fminf(a, b); a = hi_; b = lo_; } while (0)
#pragma unroll 1
                    for (int g4 = 0; g4 < 8; ++g4) {
                        float gv[16];
#pragma unroll
                        for (int n8 = 0; n8 < 2; ++n8) { const v4u x = sp[g4 * 2 + n8]; const unsigned xw[4] = {x.x, x.y, x.z, x.w};
#pragma unroll
                            for (int e = 0; e < 4; ++e) { gv[n8 * 8 + 2 * e] = __uint_as_float((xw[e] << 16) | (unsigned)(g4 * 16 + n8 * 8 + 2 * e)); gv[n8 * 8 + 2 * e + 1] = __uint_as_float((xw[e] & 0xffff0000u) | (unsigned)(g4 * 16 + n8 * 8 + 2 * e + 1)); } }
                        CEX(gv[0], gv[13]); CEX(gv[1], gv[12]); CEX(gv[2], gv[15]); CEX(gv[3], gv[14]); CEX(gv[4], gv[8]); CEX(gv[5], gv[6]); CEX(gv[7], gv[11]); CEX(gv[9], gv[10]); CEX(gv[0], gv[5]); CEX(gv[1], gv[7]); CEX(gv[2], gv[9]); CEX(gv[3], gv[4]); CEX(gv[6], gv[13]); CEX(gv[8], gv[14]); CEX(gv[10], gv[15]); CEX(gv[11], gv[12]); CEX(gv[0], gv[1]); CEX(gv[2], gv[3]); CEX(gv[4], gv[5]); CEX(gv[6], gv[8]); CEX(gv[7], gv[9]); CEX(gv[10], gv[11]); CEX(gv[12], gv[13]); CEX(gv[14], gv[15]); CEX(gv[0], gv[2]); CEX(gv[1], gv[3]); CEX(gv[4], gv[10]); CEX(gv[5], gv[11]); CEX(gv[6], gv[7]); CEX(gv[8], gv[9]); CEX(gv[12], gv[14]); CEX(gv[13], gv[15]); CEX(gv[1], gv[2]); CEX(gv[3], gv[12]); CEX(gv[4], gv[6]); CEX(gv[5], gv[7]); CEX(gv[8], gv[10]); CEX(gv[9], gv[11]); CEX(gv[13], gv[14]); CEX(gv[1], gv[4]); CEX(gv[2], gv[6]); CEX(gv[5], gv[8]); CEX(gv[7], gv[10]); CEX(gv[9], gv[13]); CEX(gv[11], gv[14]); CEX(gv[2], gv[4]); CEX(gv[3], gv[6]); CEX(gv[9], gv[12]); CEX(gv[11], gv[13]); CEX(gv[3], gv[5]); CEX(gv[6], gv[8]); CEX(gv[7], gv[9]); CEX(gv[10], gv[12]); CEX(gv[3], gv[4]); CEX(gv[5], gv[6]); CEX(gv[7], gv[8]); CEX(gv[9], gv[10]); CEX(gv[11], gv[12]); CEX(gv[6], gv[7]); CEX(gv[8], gv[9]);
                        if (g4 == 0) {
#pragma unroll
                            for (int k2 = 0; k2 < 16; ++k2) tv[k2] = gv[k2];
                        } else {
#pragma unroll
                            for (int k2 = 0; k2 < 16; ++k2) tv[k2] = fmaxf(tv[k2], gv[15 - k2]);
                            CEX(tv[0], tv[8]); CEX(tv[1], tv[9]); CEX(tv[2], tv[10]); CEX(tv[3], tv[11]); CEX(tv[4], tv[12]); CEX(tv[5], tv[13]); CEX(tv[6], tv[14]); CEX(tv[7], tv[15]); CEX(tv[0], tv[4]); CEX(tv[1], tv[5]); CEX(tv[2], tv[6]); CEX(tv[3], tv[7]); CEX(tv[8], tv[12]); CEX(tv[9], tv[13]); CEX(tv[10], tv[14]); CEX(tv[11], tv[15]); CEX(tv[0], tv[2]); CEX(tv[1], tv[3]); CEX(tv[4], tv[6]); CEX(tv[5], tv[7]); CEX(tv[8], tv[10]); CEX(tv[9], tv[11]); CEX(tv[12], tv[14]); CEX(tv[13], tv[15]); CEX(tv[0], tv[1]); CEX(tv[2], tv[3]); CEX(tv[4], tv[5]); CEX(tv[6], tv[7]); CEX(tv[8], tv[9]); CEX(tv[10], tv[11]); CEX(tv[12], tv[13]); CEX(tv[14], tv[15]);
                        }
                    }
#undef CEX
#pragma unroll
                    for (int k2 = 0; k2 < 16; ++k2) { if (hf == 0) t1[k2] = tv[k2]; else t2[k2] = tv[k2]; wq[(hf * 16 + k2) * 64 + lane] = __float_as_uint(tv[k2]); }
                }
#define CAND(i2, j2) __uint_as_float((__float_as_uint(t1[i2] + t2[j2]) & ~255u) | (unsigned)(255 - ((i2) * 16 + (j2))))
#define CEX(a, b) do { const float hi_ = fmaxf(a, b), lo_ = fminf(a, b); a = hi_; b = lo_; } while (0)
#define BSORT16() do { CEX(ts[0], ts[8]); CEX(ts[1], ts[9]); CEX(ts[2], ts[10]); CEX(ts[3], ts[11]); CEX(ts[4], ts[12]); CEX(ts[5], ts[13]); CEX(ts[6], ts[14]); CEX(ts[7], ts[15]); CEX(ts[0], ts[4]); CEX(ts[1], ts[5]); CEX(ts[2], ts[6]); CEX(ts[3], ts[7]); CEX(ts[8], ts[12]); CEX(ts[9], ts[13]); CEX(ts[10], ts[14]); CEX(ts[11], ts[15]); CEX(ts[0], ts[2]); CEX(ts[1], ts[3]); CEX(ts[4], ts[6]); CEX(ts[5], ts[7]); CEX(ts[8], ts[10]); CEX(ts[9], ts[11]); CEX(ts[12], ts[14]); CEX(ts[13], ts[15]); CEX(ts[0], ts[1]); CEX(ts[2], ts[3]); CEX(ts[4], ts[5]); CEX(ts[6], ts[7]); CEX(ts[8], ts[9]); CEX(ts[10], ts[11]); CEX(ts[12], ts[13]); CEX(ts[14], ts[15]); } while (0)
                float ts[16];
#pragma unroll
                for (int k2 = 0; k2 < 16; ++k2) ts[k2] = CAND(0, k2);
#pragma unroll
                for (int k2 = 1; k2 < 16; ++k2) ts[k2] = fmaxf(ts[k2], CAND(16 - k2, 0));
                BSORT16();
#pragma unroll
                for (int k2 = 9; k2 < 16; ++k2) ts[k2] = fmaxf(ts[k2], CAND(1, 16 - k2));
                BSORT16();
#pragma unroll
                for (int k2 = 10; k2 < 16; ++k2) ts[k2] = fmaxf(ts[k2], CAND(17 - k2, 1));
                BSORT16();
#pragma unroll
                for (int k2 = 13; k2 < 16; ++k2) ts[k2] = fmaxf(ts[k2], CAND(2, 17 - k2));
                BSORT16();
                {   float c3[3] = {CAND(3, 2), CAND(3, 3), CAND(4, 2)};
#pragma unroll
                    for (int q3 = 0; q3 < 3; ++q3) { float c = c3[q3];
#pragma unroll
                        for (int k2 = 0; k2 < 16; ++k2) { const float hi = fmaxf(ts[k2], c); c = fminf(ts[k2], c); ts[k2] = hi; } } }
#undef BSORT16
#undef CEX
#undef CAND
                LDS_WAIT(); asm volatile("" ::: "memory");
                int eo[16]; float go[16];
#pragma unroll
                for (int k2 = 0; k2 < 16; ++k2) { const unsigned id = 255u - (__float_as_uint(ts[k2]) & 255u);
                    const unsigned k1 = wq[(id >> 4) * 64 + lane] & 127u, kk2 = wq[(16 + (id & 15u)) * 64 + lane] & 127u;
                    eo[k2] = (int)(k1 * 128u + kk2); go[k2] = __expf(ts[k2] - ts[0]); }
                if (live) { int* ep = eidx + (size_t)pair * 16; float* gp = gates + (size_t)pair * 16;
#pragma unroll
                    for (int k4 = 0; k4 < 4; ++k4) { *(v4u*)(ep + 4 * k4) = (v4u){(unsigned)eo[4 * k4], (unsigned)eo[4 * k4 + 1], (unsigned)eo[4 * k4 + 2], (unsigned)eo[4 * k4 + 3]};
                        *(f32x4*)(gp + 4 * k4) = (f32x4){go[4 * k4], go[4 * k4 + 1], go[4 * k4 + 2], go[4 * k4 + 3]}; } }
                LDS_WAIT(); asm volatile("" ::: "memory");
            }
        }
        GRID_BAR(); STAMP(11); SHIFT_AT(11);
#ifndef NO_P11
        { PH_IDS
        for (int row = gw; row < MROWS; row += NGW) {
            const int b = row / SB, t = row % SB;
            if (l == 1 && t < NCTX) continue;
#ifdef PEER_FP4
            const unsigned char* Utab = Utab0 + (size_t)l * 16384 * F4_REC; const float2* sc = sct + (size_t)l * 16384;
            const int L = lane & 31; const bool hh = lane >= 32; const unsigned L16 = (unsigned)L * 16u;
            f32x2 xf2[16];
            {   const v4u* xp = (const v4u*)(hA + (size_t)row * 1024 + L * 32); const v4u x0 = xp[0], x1 = xp[1], x2 = xp[2], x3 = xp[3];
                const unsigned xw[16] = {x0.x, x0.y, x0.z, x0.w, x1.x, x1.y, x1.z, x1.w, x2.x, x2.y, x2.z, x2.w, x3.x, x3.y, x3.z, x3.w};
#pragma unroll
                for (int i = 0; i < 16; ++i) xf2[i] = f32x2{bflo(xw[i]), bfhi(xw[i])}; }
            const int e0 = eidx[(size_t)row * 128 + lane], e1 = eidx[(size_t)row * 128 + 64 + lane];
            float g0 = gates[(size_t)row * 128 + lane], g1 = gates[(size_t)row * 128 + 64 + lane];
            const float2 sc0 = sc[e0], sc1 = sc[e1];
            {   float s0 = g0, s1 = g1;
                s0 += __shfl_xor(s0, 1); s1 += __shfl_xor(s1, 1); s0 += __shfl_xor(s0, 2); s1 += __shfl_xor(s1, 2); s0 += __shfl_xor(s0, 4); s1 += __shfl_xor(s1, 4); s0 += __shfl_xor(s0, 8); s1 += __shfl_xor(s1, 8);
                g0 = g0 / s0 * sc0.y; g1 = g1 / s1 * sc1.y; }
            f32x2 acc2[16];
#pragma unroll
            for (int i = 0; i < 16; ++i) acc2[i] = f32x2{0.f, 0.f};
            v4u Au[4], Av[4], Bu[4], Bv[4];
#define PG_LOAD(U_, V_, i0) do { _Pragma("unroll") for (int k = 0; k < 4; ++k) { \
                const int ea = __builtin_amdgcn_readlane((i0) < 64 ? e0 : e1, ((i0) + 2 * k) & 63), eb = __builtin_amdgcn_readlane((i0) < 64 ? e0 : e1, ((i0) + 2 * k + 1) & 63); \
                const unsigned ro = (unsigned)(hh ? eb : ea) * (unsigned)F4_REC + L16; \
                U_[k] = *(const v4u*)(Utab + ro); V_[k] = *(const v4u*)(Utab + 512 + ro); } } while (0)
#define F4_PAIR(w, b) __builtin_amdgcn_cvt_scalef32_pk_f32_fp4((w), 1.f, (b))
#define PG_COMP(U_, V_, i0) do { float d[4]; _Pragma("unroll") for (int k = 0; k < 4; ++k) { const unsigned uw[4] = {U_[k].x, U_[k].y, U_[k].z, U_[k].w}; \
                    f32x2 pa = F4_PAIR(uw[0], 0) * xf2[0], pb = F4_PAIR(uw[0], 1) * xf2[1]; pa += F4_PAIR(uw[0], 2) * xf2[2]; pb += F4_PAIR(uw[0], 3) * xf2[3]; \
                    _Pragma("unroll") for (int q = 1; q < 4; ++q) { pa += F4_PAIR(uw[q], 0) * xf2[4 * q]; pb += F4_PAIR(uw[q], 1) * xf2[4 * q + 1]; pa += F4_PAIR(uw[q], 2) * xf2[4 * q + 2]; pb += F4_PAIR(uw[q], 3) * xf2[4 * q + 3]; } \
                    pa += pb; d[k] = pa.x + pa.y; } \
                const bool o1 = lane & 1, o2 = lane & 2; \
                float a01 = (o1 ? d[1] : d[0]) + __shfl_xor(o1 ? d[0] : d[1], 1), a23 = (o1 ? d[3] : d[2]) + __shfl_xor(o1 ? d[2] : d[3], 1); \
                float tt = (o2 ? a23 : a01) + __shfl_xor(o2 ? a01 : a23, 2); \
                tt += __shfl_xor(tt, 4); tt += __shfl_xor(tt, 8); tt += __shfl_xor(tt, 16);             \
                const int sl = (lane - (i0)) & 7; const float town = __shfl(tt, (sl & 1) * 32 + (sl >> 1));     \
                const float cown = ((i0) < 64 ? g0 : g1) * gelu_tanh(town * ((i0) < 64 ? sc0.x : sc1.x));         \
                _Pragma("unroll") for (int k = 0; k < 4; ++k) { \
                    const float ca = __uint_as_float(__builtin_amdgcn_readlane(__float_as_uint(cown), ((i0) + 2 * k) & 63)), cb = __uint_as_float(__builtin_amdgcn_readlane(__float_as_uint(cown), ((i0) + 2 * k + 1) & 63)); \
                    const float c = hh ? cb : ca; const f32x2 c2 = f32x2{c, c}; const unsigned vw[4] = {V_[k].x, V_[k].y, V_[k].z, V_[k].w}; \
                    _Pragma("unroll") for (int q = 0; q < 4; ++q) { acc2[4 * q] += c2 * F4_PAIR(vw[q], 0); acc2[4 * q + 1] += c2 * F4_PAIR(vw[q], 1); acc2[4 * q + 2] += c2 * F4_PAIR(vw[q], 2); acc2[4 * q + 3] += c2 * F4_PAIR(vw[q], 3); } } } while (0)
            PG_LOAD(Au, Av, 0);
            for (int i0 = 0; i0 < 128; i0 += 16) {
                PG_LOAD(Bu, Bv, i0 + 8);
                PG_COMP(Au, Av, i0);
                if (i0 + 16 < 128) PG_LOAD(Au, Av, i0 + 16);
                PG_COMP(Bu, Bv, i0 + 8);
            }
#undef PG_LOAD
#undef PG_COMP
#undef F4_PAIR
            float accf[16];
#pragma unroll
            for (int i = 0; i < 16; ++i) { const float ajl = (i & 1) ? acc2[i >> 1].y : acc2[i >> 1].x, ajh = (i & 1) ? acc2[8 + (i >> 1)].y : acc2[8 + (i >> 1)].x;
                const float keep = hh ? ajh : ajl, give = hh ? ajl : ajh; accf[i] = keep + __shfl_xor(give, 32); }
#else
            const unsigned char* Utab = Utab0 + (size_t)l * 16384 * F6_REC; const float2* sc = sct + (size_t)l * 16384;
            const int L = lane & 31; const bool hh = lane >= 32; const unsigned L16 = (unsigned)L * 16u, L8 = 512u + (unsigned)L * 8u;
            typedef __bf16 bf2_t __attribute__((ext_vector_type(2))); typedef __bf16 bf32_t __attribute__((ext_vector_type(32))); typedef unsigned v16u_t __attribute__((ext_vector_type(16)));
            f32x2 xf2[16];
            {   const v4u* xp = (const v4u*)(hA + (size_t)row * 1024 + L * 32); const v4u x0 = xp[0], x1 = xp[1], x2 = xp[2], x3 = xp[3];
                const unsigned xw[16] = {x0.x, x0.y, x0.z, x0.w, x1.x, x1.y, x1.z, x1.w, x2.x, x2.y, x2.z, x2.w, x3.x, x3.y, x3.z, x3.w};
#pragma unroll
                for (int i = 0; i < 16; ++i) { const int da = f6_dim(2 * i), db = f6_dim(2 * i + 1);
                    xf2[i] = f32x2{(da & 1) ? bfhi(xw[da >> 1]) : bflo(xw[da >> 1]), (db & 1) ? bfhi(xw[db >> 1]) : bflo(xw[db >> 1])}; } }
            const int e0 = eidx[(size_t)row * 128 + lane], e1 = eidx[(size_t)row * 128 + 64 + lane];
            float g0 = gates[(size_t)row * 128 + lane], g1 = gates[(size_t)row * 128 + 64 + lane];
            const float2 sc0 = sc[e0], sc1 = sc[e1];
            {   float s0 = g0, s1 = g1;
                s0 += __shfl_xor(s0, 1); s1 += __shfl_xor(s1, 1); s0 += __shfl_xor(s0, 2); s1 += __shfl_xor(s1, 2); s0 += __shfl_xor(s0, 4); s1 += __shfl_xor(s1, 4); s0 += __shfl_xor(s0, 8); s1 += __shfl_xor(s1, 8);
                g0 = g0 / s0 * sc0.y; g1 = g1 / s1 * sc1.y; }
            f32x2 acc2[16];
#pragma unroll
            for (int i = 0; i < 16; ++i) acc2[i] = f32x2{0.f, 0.f};
            v4u Au4[2], Av4[2], Bu4[2], Bv4[2]; u32x2 Au2[2], Av2[2], Bu2[2], Bv2[2];
#define PG_LOAD(U4_, U2_, V4_, V2_, i0) do { _Pragma("unroll") for (int k = 0; k < 2; ++k) { \
                const int ea = __builtin_amdgcn_readlane((i0) < 64 ? e0 : e1, ((i0) + 2 * k) & 63), eb = __builtin_amdgcn_readlane((i0) < 64 ? e0 : e1, ((i0) + 2 * k + 1) & 63); \
                const unsigned ro = (unsigned)(hh ? eb : ea) * (unsigned)F6_REC, o16 = ro + L16, o8 = ro + L8;        \
                U4_[k] = *(const v4u*)(Utab + o16); U2_[k] = *(const u32x2*)(Utab + o8); V4_[k] = *(const v4u*)(Utab + 768 + o16); V2_[k] = *(const u32x2*)(Utab + 768 + o8); } } while (0)
#define PG_COMP(U4_, U2_, V4_, V2_, i0) do { float d[2]; _Pragma("unroll") for (int k = 0; k < 2; ++k) { \
                    const v32f r = __builtin_amdgcn_cvt_scalef32_pk32_f32_fp6(v6u{U4_[k].x, U4_[k].y, U4_[k].z, U4_[k].w, U2_[k].x, U2_[k].y}, 1.f); \
                    f32x2 pa = f32x2{r[0], r[1]} * xf2[0], pb = f32x2{r[2], r[3]} * xf2[1]; \
                    _Pragma("unroll") for (int i = 2; i < 16; i += 2) { pa += f32x2{r[2 * i], r[2 * i + 1]} * xf2[i]; pb += f32x2{r[2 * i + 2], r[2 * i + 3]} * xf2[i + 1]; } \
                    pa += pb; d[k] = pa.x + pa.y; } \
                const bool o1 = lane & 1; \
                float tt = (o1 ? d[1] : d[0]) + __shfl_xor(o1 ? d[0] : d[1], 1); \
                tt += __shfl_xor(tt, 2); tt += __shfl_xor(tt, 4); tt += __shfl_xor(tt, 8); tt += __shfl_xor(tt, 16);             \
                const int sl = (lane - (i0)) & 3; const float town = __shfl(tt, (sl & 1) * 32 + (sl >> 1));     \
                const float cown = ((i0) < 64 ? g0 : g1) * gelu_tanh(town * ((i0) < 64 ? sc0.x : sc1.x));         \
                _Pragma("unroll") for (int k = 0; k < 2; ++k) { \
                    const float ca = __uint_as_float(__builtin_amdgcn_readlane(__float_as_uint(cown), ((i0) + 2 * k) & 63)), cb = __uint_as_float(__builtin_amdgcn_readlane(__float_as_uint(cown), ((i0) + 2 * k + 1) & 63)); \
                    const float c = hh ? cb : ca; \
                    const v32f r = __builtin_amdgcn_cvt_scalef32_pk32_f32_fp6(v6u{V4_[k].x, V4_[k].y, V4_[k].z, V4_[k].w, V2_[k].x, V2_[k].y}, 1.f); \
                    const f32x2 c2 = f32x2{c, c}; \
                    _Pragma("unroll") for (int i = 0; i < 16; ++i) acc2[i] += c2 * f32x2{r[2 * i], r[2 * i + 1]}; } } while (0)
            PG_LOAD(Au4, Au2, Av4, Av2, 0);
            for (int i0 = 0; i0 < 128; i0 += 8) {
                PG_LOAD(Bu4, Bu2, Bv4, Bv2, i0 + 4);
                PG_COMP(Au4, Au2, Av4, Av2, i0);
                if (i0 + 8 < 128) PG_LOAD(Au4, Au2, Av4, Av2, i0 + 8);
                PG_COMP(Bu4, Bu2, Bv4, Bv2, i0 + 4);
            }
#undef PG_LOAD
#undef PG_COMP
            float accf[16];
#pragma unroll
            for (int i = 0; i < 16; ++i) { const int jl = F6_INTERLEAVED ? 2 * i : i, jh = F6_INTERLEAVED ? 2 * i + 1 : 16 + i;
                const float ajl = (jl & 1) ? acc2[jl >> 1].y : acc2[jl >> 1].x, ajh = (jh & 1) ? acc2[jh >> 1].y : acc2[jh >> 1].x;
                const float keep = hh ? ajh : ajl, give = hh ? ajl : ajh; accf[i] = keep + __shfl_xor(give, 32); }
#endif
            int lane2 = threadIdx.x & 63; asm volatile("" : "+v"(lane2)); lane2 = 2 * (lane2 & 31) + (lane2 >> 5);
            const float* g2 = (mod + l * 9 * 6144) + (t < NCTX ? 8 : b) * 6144 + 5 * 1024;
            bf16* sp = strm + (size_t)row * DM_;
            float sv_[16]; float ss = 0.f;
#pragma unroll
            for (int q = 0; q < 4; ++q) { const int c = lane2 * 16 + q * 4; const u32x2 sw = *(const u32x2*)(sp + c); const f32x4 s = f32x4{bflo(sw.x), bfhi(sw.x), bflo(sw.y), bfhi(sw.y)}, gg = *(const f32x4*)(g2 + c);
#pragma unroll
                for (int j = 0; j < 4; ++j) { const float v = s[j] + gg[j] * accf[q * 4 + j]; sv_[q * 4 + j] = v; ss += v * v; } }
            const float r = rsqrtf(wave_sum(ss) * (1.f / DM_) + EPS_);
            if (l == 0) {
#pragma unroll
                for (int q = 0; q < 4; ++q) { const int c = lane2 * 16 + q * 4; u32x2 w; w.x = pk2(sv_[q * 4], sv_[q * 4 + 1]); w.y = pk2(sv_[q * 4 + 2], sv_[q * 4 + 3]); *(u32x2*)(sp + c) = w; }
                const float* m1 = mod + (9 + (t < NCTX ? 8 : b)) * 6144; const float* gam = norm1_g + 1024;
#pragma unroll
                for (int hf = 0; hf < 2; ++hf) { const int c = lane2 * 16 + hf * 8; float o[8];
#pragma unroll
                    for (int j = 0; j < 8; ++j) o[j] = sv_[hf * 8 + j] * r * gam[c + j] * (1.f + m1[1024 + c + j]) + m1[c + j];
                    v4u w; w.x = pk2(o[0], o[1]); w.y = pk2(o[2], o[3]); w.z = pk2(o[4], o[5]); w.w = pk2(o[6], o[7]);
                    *(v4u*)(hA + (size_t)row * 1024 + c) = w; }
            } else {
                float* op = out + ((size_t)b * SEQ + (t - NCTX)) * DM_;
#pragma unroll
                for (int q = 0; q < 4; ++q) { const int c = lane2 * 16 + q * 4; const f32x4 gg = *(const f32x4*)(fng + c);
                    *(f32x4*)(op + c) = (f32x4){sv_[q * 4] * r * gg[0], sv_[q * 4 + 1] * r * gg[1], sv_[q * 4 + 2] * r * gg[2], sv_[q * 4 + 3] * r * gg[3]}; }
            }
        }
        }
#endif
        if (l == 0) { GRID_BAR(); STAMP(12); }
    }
#ifdef F6_DIAG
    GRID_BAR();
    if (blockIdx.x == 0 && threadIdx.x == 0) { KArgsP A_ = (KArgsP)__builtin_amdgcn_kernarg_segment_ptr(); const float* dg = (const float*)(A_->ws + WS_SCT) + 2 * 32768;
        const float code = (dg[2] < 1e-3f ? 1.f : 2.f) * 10000.f + (dg[0] < 0.07f ? 1.f : 2.f) * 1000.f;
        A_->out[0] = code; }
#endif
#ifdef TIMING_MASK
    GRID_BAR(); STAMP(12);
    if (blockIdx.x == 0 && threadIdx.x == 0) { volatile LAS unsigned long long* tq = (volatile LAS unsigned long long*)((LAS unsigned char*)lds + LDSCTL_OFF + 64); unsigned long long s = 0;
        for (int p = 0; p < 13; ++p) if ((TIMING_MASK >> p) & 1) s += tq[1 + p];
        KArgsP T_ = (KArgsP)__builtin_amdgcn_kernarg_segment_ptr(); T_->out[0] = (float)s * TIMING_UNIT; }
#endif
}

extern "C" void kernel_launch(void* const* d_in, const int* in_sizes, int n_in, void* d_out, int out_size, void* d_ws, size_t ws_size, hipStream_t stream) {
    static int grid = 0;
    if (grid == 0) {
        int dev = 0, cus = 0, per_cu = 0;
        if (n_in != 32 || ws_size < WS_END) { fprintf(stderr, "kernel_launch: unexpected n_in %d / ws %zu\n", n_in, ws_size); grid = -1; return; }
        if (hipGetDevice(&dev) != hipSuccess || hipDeviceGetAttribute(&cus, hipDeviceAttributeMultiprocessorCount, dev) != hipSuccess) { grid = -1; return; }
        if (hipFuncSetAttribute((const void*)mk_fwd, hipFuncAttributeMaxDynamicSharedMemorySize, LDS_BYTES) != hipSuccess) { fprintf(stderr, "kernel_launch: hipFuncSetAttribute failed\n"); grid = -1; return; }
        if (hipOccupancyMaxActiveBlocksPerMultiprocessor(&per_cu, (const void*)mk_fwd, NWAVES * 64, LDS_BYTES) != hipSuccess || per_cu < 1) { fprintf(stderr, "kernel_launch: occupancy query says %d\n", per_cu); per_cu = 1; }
        (void)hipGetLastError();
        grid = cus;
    }
    if (grid < 0) return;
    (void)hipMemsetAsync((char*)d_ws + WS_CTL, 0, CTL_ZERO_BYTES, stream);
    Args a{};
    for (int i = 0; i < 32; ++i) a.in[i] = (const float*)d_in[i];
    a.out = (float*)d_out; a.ws = (unsigned char*)d_ws;
    void* kargs[] = {&a};
    hipError_t e = hipLaunchCooperativeKernel((const void*)mk_fwd, dim3(grid), dim3(NWAVES * 64), kargs, LDS_BYTES, stream);
    if (e != hipSuccess) fprintf(stderr, "kernel_launch: cooperative launch failed: %s (grid %d)\n", hipGetErrorString(e), grid);
}
```

```cpp
#ifndef PEER_FP6
#define PEER_FP4 1
#endif
#include <hip/hip_runtime.h>
#include <hip/hip_bf16.h>
#include <cstdio>
#include <cstdint>
#include <math.h>

constexpr int DM_ = 1024, NB = 8, SEQ = 2048, NCTX = 256, SB = SEQ + NCTX, MROWS = NB * SB;
constexpr int INW = 6416, PW = 6656;
#define ATT_PITCH_ELEMS 6656
constexpr int PC_US = 0, PC_QA = 512, PC_KA = 1024, PC_VA = 1152, PC_QM = 1280, PC_KM = 1792, PC_VM = 2304, PC_OM = 2816, PC_GL = 3328, PC_GM = 6400;
constexpr float EPS_ = 1e-6f;

namespace pg8 {
#define PG8_LAS __attribute__((address_space(3)))
typedef unsigned short bf16_t;
typedef short bf16x8 __attribute__((ext_vector_type(8)));
typedef float f32x4 __attribute__((ext_vector_type(4)));
typedef unsigned u32x4 __attribute__((ext_vector_type(4)));
constexpr int BM = 256, BK = 64, HALF = 128, HTB = HALF * BK * 2  , STAGE_BYTES = 8 * HTB, NXCD = 8, WGM = 4;

__host__ __device__ __forceinline__ int lds_byte(int r, int c) { const int st = (r >> 4) * 2 + (c >> 5), rr = r & 15, cc = c & 31, ob = rr * 64 + cc * 2; return st * 1024 + (ob ^ (((ob >> 9) & 1) << 5)); }
__host__ __device__ __forceinline__ void stage_rc(int b, int& R, int& C) { const int st = b / 1024, sb = b % 1024, swz = sb ^ (((sb >> 9) & 1) << 5); R = (st >> 1) * 16 + swz / 64; C = (st & 1) * 32 + (swz % 64) / 2; }
__host__ __device__ __forceinline__ int perm32(int rho) { const int n = rho >> 4, i = rho & 15; return 8 * (i >> 2) + 4 * n + (i & 3); }

struct Unit { int pm, pn; };
struct Gemm { const bf16_t* A; const bf16_t* Bt; int M, N, K, lda, ldb; };

struct StaticOrder {
    int nM, nN, nwg, G, c;
    __host__ __device__ void init(int M, int N, int G_, int c_) { nM = M / BM; nN = N / BM; nwg = nM * nN; G = G_; c = c_; }
    __host__ __device__ bool next(int i, Unit& u) const {
        const long L = (long)i * G + c; if (L >= nwg) return false;
        int wgid = (int)L; { const int q = nwg / NXCD, r = nwg % NXCD, xcd = wgid % NXCD, off = wgid / NXCD; wgid = (xcd < r ? xcd * (q + 1) : r * (q + 1) + (xcd - r) * q) + off; }
        const int nig = WGM * nN, gid = wgid / nig, fm = gid * WGM, gsz = (nM - fm) < WGM ? (nM - fm) : WGM;
        u.pm = fm + ((wgid % nig) % gsz); u.pn = (wgid % nig) / gsz; return true;
    }
    __device__ __forceinline__ void a_ready(const Unit&) const {}
    __device__ __forceinline__ void done(const Unit&) const {}
};

__device__ __forceinline__ unsigned cvt_pk_bf16(float lo, float hi) { unsigned r; asm volatile("v_cvt_pk_bf16_f32 %0, %1, %2" : "=v"(r) : "v"(lo), "v"(hi)); return r; }
typedef float f32x2 __attribute__((ext_vector_type(2)));
__device__ __forceinline__ f32x2 gelu_pk(f32x2 v) {
    const f32x2 av = __builtin_elementwise_abs(v), d = av * 0.2316418882f + 1.0f;
    f32x2 t; t.x = __builtin_amdgcn_rcpf(d.x); t.y = __builtin_amdgcn_rcpf(d.y);
    f32x2 q = t * 0.5307027145f + (-0.7265760135f); q = q * t + 0.7107068705f; q = q * t + (-0.142248368f); q = q * t + 0.127414796f; q = q * t;
    const f32x2 s = (v * v) * (-0.72134752044f);
    f32x2 e; e.x = __builtin_amdgcn_exp2f(s.x); e.y = __builtin_amdgcn_exp2f(s.y);
    const f32x2 m = v * (q * e), r = v - m;
    f32x2 o; o.x = v.x < 0.f ? m.x : r.x; o.y = v.y < 0.f ? m.y : r.y; return o;
}

template <int ACT  > struct EpiBf16 {
    static constexpr bool PERM = true, AFTER_DRAIN = false; static_assert(ACT == 0 || ACT == 1, "EpiBf16: ACT is 0 (none) or 1 (gelu_pk)");
    bf16_t* O; int ldc; const float* bias; int split_cols; size_t split_stride; float scale0;
    __device__ __forceinline__ void operator()(const f32x4 (&acc)[2][2][4][2], const Unit& u, int wr, int wc, int fr, int fq) const {
        const int row0 = u.pm * BM + wr * 64 + fr; int colt = u.pn * BM; bf16_t* base = O;
        float sc = 1.f; if (split_cols) { const int t = colt / split_cols; base += (size_t)t * split_stride; colt -= t * split_cols; if (t == 0) sc = scale0; }
        const int col0 = colt + wc * 32 + 8 * fq, bcol0 = u.pn * BM + wc * 32 + 8 * fq;
        f32x4 bv[2][2];
#pragma unroll
        for (int bj = 0; bj < 2; ++bj)
#pragma unroll
            for (int n = 0; n < 2; ++n) bv[bj][n] = bias ? *(const f32x4*)(bias + bcol0 + bj * HALF + 4 * n) : (f32x4){0.f, 0.f, 0.f, 0.f};
#pragma unroll
        for (int ai = 0; ai < 2; ++ai)
#pragma unroll
            for (int m = 0; m < 4; ++m) { bf16_t* rowp = base + (size_t)(row0 + ai * HALF + m * 16) * ldc + col0;
#pragma unroll
                for (int bj = 0; bj < 2; ++bj) { f32x4 v0 = acc[ai][bj][m][0] + bv[bj][0], v1 = acc[ai][bj][m][1] + bv[bj][1];
                    if (ACT == 1) { f32x2 a = gelu_pk((f32x2){v0[0], v0[1]}), b = gelu_pk((f32x2){v0[2], v0[3]}), c = gelu_pk((f32x2){v1[0], v1[1]}), d = gelu_pk((f32x2){v1[2], v1[3]});
                        v0 = (f32x4){a.x, a.y, b.x, b.y}; v1 = (f32x4){c.x, c.y, d.x, d.y}; }
                    v0 = v0 * sc; v1 = v1 * sc; u32x4 w; w.x = cvt_pk_bf16(v0[0], v0[1]); w.y = cvt_pk_bf16(v0[2], v0[3]); w.z = cvt_pk_bf16(v1[0], v1[1]); w.w = cvt_pk_bf16(v1[2], v1[3]);
                    *(u32x4*)(rowp + bj * HALF) = w; } }
    }
};
template <class Epi, class Sched, bool ALIGN_EPI = false, bool SP2 = false>
__device__ __forceinline__ void gemm_phase(PG8_LAS unsigned char* lds, const Gemm g, const Sched& S, const Epi& E) {
    int tid_l = threadIdx.x; asm volatile("" : "+v"(tid_l)); const int tid = tid_l, wid = __builtin_amdgcn_readfirstlane(tid >> 6), lane = tid & 63, wr = wid >> 2, wc = wid & 3, fr = lane & 15, fq = lane >> 4;
    const int K = g.K, nt = K / BK;
    unsigned voffA[2], voffB[2];
#pragma unroll
    for (int i = 0; i < 2; ++i) { int R, C; stage_rc(tid * 16 + i * 8192, R, C); const int Rb = Epi::PERM ? ((R & ~31) + perm32(R & 31)) : R;
        voffA[i] = (unsigned)(R * g.lda + C) * 2u; voffB[i] = (unsigned)(Rb * g.ldb + C) * 2u; }
    const size_t kstep = (size_t)(BK * 2);
    const size_t hstepA = (size_t)HALF * g.lda * 2, hstepB = (size_t)HALF * g.ldb * 2;
    const size_t tstepA = 2 * hstepA, tstepB = 2 * hstepB;
    const unsigned ldsw = (unsigned)wid * 1024u;
    const int aoff = lds_byte(wr * 64 + fr, fq * 8), boff = lds_byte(wc * 32 + fr, fq * 8);
#define PG8_SA(b, h) (((b) * 2 + (h)) * HTB)
#define PG8_SB(b, h) ((4 + (b) * 2 + (h)) * HTB)
#define PG8_STAGE(bufoff, gbase, voff) do { _Pragma("unroll") for (int _i = 0; _i < 2; ++_i) \
        __builtin_amdgcn_global_load_lds((const unsigned*)((const char*)(gbase) + (voff)[_i]), (PG8_LAS unsigned*)(lds + (bufoff) + ldsw + _i * 8192), 16, 0, 0); } while (0)
#define PG8_LDA(dst, b, h) do { _Pragma("unroll") for (int m = 0; m < 4; ++m) _Pragma("unroll") for (int k = 0; k < 2; ++k) dst[m][k] = *(const PG8_LAS bf16x8*)(lds + PG8_SA(b, h) + aoff + m * 2048 + k * 1024); } while (0)
#define PG8_LDB(dst, b, h) do { _Pragma("unroll") for (int n = 0; n < 2; ++n) _Pragma("unroll") for (int k = 0; k < 2; ++k) dst[n][k] = *(const PG8_LAS bf16x8*)(lds + PG8_SB(b, h) + boff + n * 2048 + k * 1024); } while (0)
#define PG8_MMA(ai, bj, At, Bt) do { __builtin_amdgcn_s_setprio(1); _Pragma("unroll") for (int m = 0; m < 4; ++m) _Pragma("unroll") for (int n = 0; n < 2; ++n) _Pragma("unroll") for (int k = 0; k < 2; ++k) \
        acc[ai][bj][m][n] = __builtin_amdgcn_mfma_f32_16x16x32_bf16(Bt[n][k], At[m][k], acc[ai][bj][m][n], 0, 0, 0); __builtin_amdgcn_s_setprio(0); } while (0)
#define PG8_WAIT_V(n) asm volatile("s_waitcnt vmcnt(" #n ")" ::: "memory")
#define PG8_WAIT_L(n) asm volatile("s_waitcnt lgkmcnt(" #n ")" ::: "memory")
#define PG8_BAR __builtin_amdgcn_s_barrier()
#define PG8_SCHED __builtin_amdgcn_sched_barrier(0)
    Unit cur, nxt; int ui = 0;
    if (!S.next(0, cur)) return;
    f32x4 acc[2][2][4][2];
#pragma unroll
    for (int a = 0; a < 2; ++a)
#pragma unroll
        for (int b = 0; b < 2; ++b)
#pragma unroll
            for (int m = 0; m < 4; ++m)
#pragma unroll
                for (int n = 0; n < 2; ++n) acc[a][b][m][n] = (f32x4){0.f, 0.f, 0.f, 0.f};
    bf16x8 At[4][2], B0[2][2], B1[2][2];
    const char* cA = (const char*)g.A + (size_t)cur.pm * tstepA; const char* cB = (const char*)g.Bt + (size_t)cur.pn * tstepB;
    S.a_ready(cur);
    if constexpr (SP2) {
        PG8_STAGE(PG8_SB(0, 0), cB, voffB); PG8_STAGE(PG8_SB(0, 1), cB + hstepB, voffB); PG8_STAGE(PG8_SA(0, 0), cA, voffA); PG8_STAGE(PG8_SA(0, 1), cA + hstepA, voffA);
        if (wr == 1) PG8_BAR;
        PG8_WAIT_V(2); PG8_BAR;
        PG8_STAGE(PG8_SB(1, 0), cB + kstep, voffB); PG8_STAGE(PG8_SA(1, 0), cA + kstep, voffA); PG8_STAGE(PG8_SB(1, 1), cB + hstepB + kstep, voffB);
        PG8_WAIT_V(6); PG8_BAR;
    } else {
        PG8_STAGE(PG8_SB(0, 0), cB, voffB); PG8_STAGE(PG8_SA(0, 0), cA, voffA); PG8_STAGE(PG8_SB(0, 1), cB + hstepB, voffB); PG8_STAGE(PG8_SA(0, 1), cA + hstepA, voffA);
        if (wr == 1) PG8_BAR;
        PG8_WAIT_V(4); PG8_BAR;
        PG8_STAGE(PG8_SB(1, 0), cB + kstep, voffB); PG8_STAGE(PG8_SA(1, 0), cA + kstep, voffA); PG8_STAGE(PG8_SB(1, 1), cB + hstepB + kstep, voffB);
        PG8_WAIT_V(6); PG8_BAR;
    }
    for (;;) {
        const bool has_next = S.next(ui + 1, nxt);
        const char* nA = has_next ? (const char*)g.A + (size_t)nxt.pm * tstepA : cA; const char* nB = has_next ? (const char*)g.Bt + (size_t)nxt.pn * tstepB : cB;
        for (int t = 0; t < nt; t += 2) {
            const bool last = (t == nt - 2);
            const char* a1 = cA + (size_t)(t + 1) * kstep;
            const char* a2 = last ? nA : cA + (size_t)(t + 2) * kstep; const char* b2 = last ? nB : cB + (size_t)(t + 2) * kstep;
            const char* a3 = a2 + kstep; const char* b3 = b2 + kstep;
            if (last && has_next) S.a_ready(nxt);
            if constexpr (SP2) {
            PG8_LDB(B0, 0, 0); PG8_LDB(B1, 0, 1); PG8_SCHED; PG8_LDA(At, 0, 0); PG8_STAGE(PG8_SA(1, 1), a1 + hstepA, voffA);
            PG8_WAIT_V(8); PG8_WAIT_L(0); PG8_BAR; PG8_MMA(0, 0, At, B0); PG8_MMA(0, 1, At, B1); PG8_BAR; PG8_SCHED;
            PG8_LDA(At, 0, 1); PG8_STAGE(PG8_SB(0, 0), b2, voffB); PG8_STAGE(PG8_SB(0, 1), b2 + hstepB, voffB); PG8_STAGE(PG8_SA(0, 0), a2, voffA);
            PG8_WAIT_V(8); PG8_WAIT_L(0); PG8_BAR; PG8_MMA(1, 0, At, B0); PG8_MMA(1, 1, At, B1); PG8_BAR; PG8_SCHED;
            PG8_LDB(B0, 1, 0); PG8_LDB(B1, 1, 1); PG8_SCHED; PG8_LDA(At, 1, 0); PG8_STAGE(PG8_SA(0, 1), a2 + hstepA, voffA);
            PG8_WAIT_V(8); PG8_WAIT_L(0); PG8_BAR; PG8_MMA(0, 0, At, B0); PG8_MMA(0, 1, At, B1); PG8_BAR; PG8_SCHED;
            PG8_LDA(At, 1, 1); PG8_STAGE(PG8_SB(1, 0), b3, voffB); PG8_STAGE(PG8_SB(1, 1), b3 + hstepB, voffB); PG8_STAGE(PG8_SA(1, 0), a3, voffA);
            PG8_WAIT_V(8); PG8_WAIT_L(0); PG8_BAR; PG8_MMA(1, 0, At, B0); PG8_MMA(1, 1, At, B1); PG8_BAR; PG8_SCHED;
            } else {
            PG8_LDB(B0, 0, 0); PG8_SCHED; PG8_LDA(At, 0, 0); PG8_STAGE(PG8_SA(1, 1), a1 + hstepA, voffA);
            PG8_WAIT_L(8); PG8_BAR; PG8_WAIT_L(0); PG8_MMA(0, 0, At, B0); PG8_BAR; PG8_SCHED;
            PG8_LDB(B1, 0, 1); PG8_STAGE(PG8_SB(0, 0), b2, voffB);
            PG8_BAR; PG8_WAIT_L(0); PG8_MMA(0, 1, At, B1); PG8_BAR;
            PG8_LDA(At, 0, 1); PG8_STAGE(PG8_SA(0, 0), a2, voffA);
            PG8_BAR; PG8_WAIT_L(0); PG8_MMA(1, 0, At, B0); PG8_BAR; PG8_SCHED;
            PG8_STAGE(PG8_SB(0, 1), b2 + hstepB, voffB);
            PG8_WAIT_V(6); PG8_BAR; PG8_MMA(1, 1, At, B1); PG8_BAR;
            PG8_LDB(B0, 1, 0); PG8_SCHED; PG8_LDA(At, 1, 0); PG8_STAGE(PG8_SA(0, 1), a2 + hstepA, voffA);
            PG8_WAIT_L(8); PG8_BAR; PG8_WAIT_L(0); PG8_MMA(0, 0, At, B0); PG8_BAR; PG8_SCHED;
            PG8_LDB(B1, 1, 1); PG8_STAGE(PG8_SB(1, 0), b3, voffB);
            PG8_BAR; PG8_WAIT_L(0); PG8_MMA(0, 1, At, B1); PG8_BAR;
            PG8_LDA(At, 1, 1); PG8_STAGE(PG8_SA(1, 0), a3, voffA);
            PG8_BAR; PG8_WAIT_L(0); PG8_MMA(1, 0, At, B0); PG8_BAR; PG8_SCHED;
            PG8_STAGE(PG8_SB(1, 1), b3 + hstepB, voffB);
            PG8_WAIT_V(6); PG8_BAR; PG8_MMA(1, 1, At, B1); PG8_BAR;
            }
        }
        if constexpr (ALIGN_EPI) { if (wr == 0) PG8_BAR; }
        if constexpr (!Epi::AFTER_DRAIN) { E(acc, cur, wr, wc, fr, fq); S.done(cur); }
        if (!has_next) break;
#pragma unroll
        for (int a = 0; a < 2; ++a)
#pragma unroll
            for (int b = 0; b < 2; ++b)
#pragma unroll
                for (int m = 0; m < 4; ++m)
#pragma unroll
                    for (int n = 0; n < 2; ++n) acc[a][b][m][n] = (f32x4){0.f, 0.f, 0.f, 0.f};
        cur = nxt; cA = nA; cB = nB; ++ui;
        if constexpr (ALIGN_EPI) { if (wr == 1) PG8_BAR; }
    }
    PG8_WAIT_V(0);
    if constexpr (!ALIGN_EPI) { if (wr == 0) PG8_BAR; }
    PG8_BAR;
    if constexpr (Epi::AFTER_DRAIN) { E.fused(acc, cur, wr, wc, fr, fq, lds, wid, lane); S.done(cur); }
#undef PG8_SA
#undef PG8_SB
#undef PG8_STAGE
#undef PG8_LDA
#undef PG8_LDB
#undef PG8_MMA
#undef PG8_WAIT_V
#undef PG8_WAIT_L
#undef PG8_BAR
#undef PG8_SCHED
}
}
#include <hip/hip_bf16.h>
#include <cmath>
namespace attn_body {
using bf16=__hip_bfloat16;
using bf16x8=__attribute__((ext_vector_type(8)))short;
using s16x4=__attribute__((ext_vector_type(4)))short;
using f32x16=__attribute__((ext_vector_type(16)))float;
using u32x4=__attribute__((ext_vector_type(4)))unsigned;
constexpr int D=64,DM=ATT_PITCH_ELEMS;
constexpr int NW=8,QBLK=32,QB=QBLK*NW,KVBLK=64;
constexpr int ATTN_UNIT_ROWS=QB;
__device__ __forceinline__ int crow(int r,int hi){return (r&3)+8*(r>>2)+4*hi;}
#define SBAR() __builtin_amdgcn_sched_barrier(0)
__device__ __forceinline__ void cmask(f32x16&p0,f32x16&p1,int jb,int qrel,int hi){
  const float NEG=-INFINITY; int kb=64*jb+4*hi;
  #pragma unroll
  for(int r=0;r<16;++r){int kv=kb+(r&3)+8*(r>>2); if(kv>qrel)p0[r]=NEG; if(kv+32>qrel)p1[r]=NEG;}
}

constexpr int NSLOT=3, SLOTB=8192;
constexpr int LDS_K=0, LDS_V=NSLOT*SLOTB, LDS_WS=2*NSLOT*SLOTB, LDS_OST=LDS_WS+NW*64*4, LDS_BYTES=LDS_OST+NW*4096;
constexpr float C2=0.125f*1.4426950408889634f;
__device__ __forceinline__ void glds16(const void*gsrc,unsigned lds_dst){unsigned keep;
  asm volatile("s_mov_b32 %0, m0\n\ts_mov_b32 m0, %2\n\ts_nop 0\n\tglobal_load_lds_dwordx4 %1, off\n\ts_mov_b32 m0, %0":"=&s"(keep):"v"(gsrc),"s"(lds_dst):"memory");}
__device__ __forceinline__ float max3f(float a,float b,float c){float r;asm("v_max3_f32 %0, %1, %2, %3":"=v"(r):"v"(a),"v"(b),"v"(c));return r;}
__device__ __forceinline__ float max2f(float a,float b){float r;asm("v_max_f32_e32 %0, %1, %2":"=v"(r):"v"(a),"v"(b));return r;}
__device__ __forceinline__ float fadd_s(float a,float b){float r;asm("v_add_f32_e32 %0, %1, %2":"=v"(r):"v"(a),"v"(b));return r;}
__device__ __forceinline__ float fsub_s(float a,float b){float r;asm("v_sub_f32_e32 %0, %1, %2":"=v"(r):"v"(a),"v"(b));return r;}
typedef float f32x2_t __attribute__((ext_vector_type(2))); typedef __bf16 bf16x2_t __attribute__((ext_vector_type(2)));
__device__ __forceinline__ unsigned cvtpk_s(float lo,float hi){f32x2_t v={lo,hi};bf16x2_t b=__builtin_convertvector(v,bf16x2_t);return __builtin_bit_cast(unsigned,b);}
#define WAIT_BAR(N) asm volatile("s_waitcnt vmcnt(" #N ") lgkmcnt(0)\n\ts_barrier":::"memory")

__device__ __forceinline__ void qkt(f32x16&p0,f32x16&p1,const char*Kslot,const bf16x8*qr,const f32x16&negm,int r32,int hi){
  const char*kb=Kslot+hi*1024+r32*16;
  #pragma unroll
  for(int d0=0;d0<4;++d0){
    const bf16x8 b0=*reinterpret_cast<const bf16x8*>(kb+d0*2048);
    const bf16x8 b1=*reinterpret_cast<const bf16x8*>(kb+d0*2048+512);
    if(d0==0){p0=__builtin_amdgcn_mfma_f32_32x32x16_bf16(b0,qr[0],negm,0,0,0);p1=__builtin_amdgcn_mfma_f32_32x32x16_bf16(b1,qr[0],negm,0,0,0);}
    else{p0=__builtin_amdgcn_mfma_f32_32x32x16_bf16(b0,qr[d0],p0,0,0,0);p1=__builtin_amdgcn_mfma_f32_32x32x16_bf16(b1,qr[d0],p1,0,0,0);}}
}
typedef __attribute__((address_space(3))) const char* lds_cptr;
typedef short v4i16_t __attribute__((ext_vector_type(4)));
__device__ __forceinline__ void kload8(bf16x8*kf,lds_cptr kp){
  kf[0]=*(const __attribute__((address_space(3))) bf16x8*)(kp);      kf[1]=*(const __attribute__((address_space(3))) bf16x8*)(kp+512);
  kf[2]=*(const __attribute__((address_space(3))) bf16x8*)(kp+2048); kf[3]=*(const __attribute__((address_space(3))) bf16x8*)(kp+2560);
  kf[4]=*(const __attribute__((address_space(3))) bf16x8*)(kp+4096); kf[5]=*(const __attribute__((address_space(3))) bf16x8*)(kp+4608);
  kf[6]=*(const __attribute__((address_space(3))) bf16x8*)(kp+6144); kf[7]=*(const __attribute__((address_space(3))) bf16x8*)(kp+6656);
}
__device__ __forceinline__ void kload2(bf16x8*kf,lds_cptr kp,int j){ kf[2*j]=*(const __attribute__((address_space(3))) bf16x8*)(kp+j*2048); kf[2*j+1]=*(const __attribute__((address_space(3))) bf16x8*)(kp+j*2048+512); }
__device__ __forceinline__ s16x4 vtr(lds_cptr p){ return __builtin_bit_cast(s16x4,__builtin_amdgcn_ds_read_tr16_b64_v4i16((__attribute__((address_space(3))) v4i16_t*)p)); }
__device__ __forceinline__ float rowmax(const f32x16&p0,const f32x16&p1){
  float a=max3f(p0[0],p0[1],p1[0]),b=max3f(p0[2],p0[3],p1[1]);a=max3f(a,p1[2],p1[3]);
  #pragma unroll
  for(int r=4;r<16;r+=4){a=max3f(a,p0[r],p0[r+1]);b=max3f(b,p0[r+2],p0[r+3]);a=max3f(a,p1[r],p1[r+1]);b=max3f(b,p1[r+2],p1[r+3]);}
  const float m=max2f(a,b);
  auto rr=__builtin_amdgcn_permlane32_swap(__float_as_uint(m),__float_as_uint(m),false,false);
  return max2f(__uint_as_float(rr[0]),__uint_as_float(rr[1]));
}
__device__ __forceinline__ void pv(f32x16*o,int vb,bf16x8 pa0,bf16x8 pa1,bf16x8 pa2,bf16x8 pa3){
  #pragma unroll
  for(int d0=0;d0<2;++d0){s16x4 lo[4],hi[4];
    #pragma unroll
    for(int ks=0;ks<4;++ks){
      asm volatile("ds_read_b64_tr_b16 %0,%1 offset:%c2":"=&v"(lo[ks]):"v"(vb),"i"(d0*4096+ks*1024):"memory");
      asm volatile("ds_read_b64_tr_b16 %0,%1 offset:%c2":"=&v"(hi[ks]):"v"(vb),"i"(d0*4096+ks*1024+512):"memory");}
    asm volatile("s_waitcnt lgkmcnt(0)":::"memory");SBAR();
    #define PK(k) (bf16x8){lo[k][0],lo[k][1],lo[k][2],lo[k][3],hi[k][0],hi[k][1],hi[k][2],hi[k][3]}
    o[d0]=__builtin_amdgcn_mfma_f32_32x32x16_bf16(pa0,PK(0),o[d0],0,0,0);
    o[d0]=__builtin_amdgcn_mfma_f32_32x32x16_bf16(pa1,PK(1),o[d0],0,0,0);
    o[d0]=__builtin_amdgcn_mfma_f32_32x32x16_bf16(pa2,PK(2),o[d0],0,0,0);
    o[d0]=__builtin_amdgcn_mfma_f32_32x32x16_bf16(pa3,PK(3),o[d0],0,0,0);
    #undef PK
  }
}

#ifndef ATTN_STORE16
#define ATTN_STORE16(p,v) (*(u32x4*)(p)=(v))
#endif
template<int THRL> __device__ __forceinline__ void attn_unit(const bf16*Qu,const bf16*__restrict__ Kh,const bf16*__restrict__ Vh,bf16*Ou,const int NT,char*shm){
  int tid_l=threadIdx.x; asm volatile("":"+v"(tid_l)); const int tid=tid_l,lane=tid&63,r32=lane&31,hi=lane>>5; const int wid=__builtin_amdgcn_readfirstlane(tid>>6);
  const bf16*Qw=Qu+(long)(wid*QBLK)*DM;
  const unsigned lds0=(unsigned)(uintptr_t)shm;
  float*wsf=(float*)(shm+LDS_WS)+wid*64;
  const bf16*ksrc=Kh+(long)lane*DM+wid*8;
  const bf16*vsrc=Vh+(long)(16*(wid&3)+(lane>>2))*DM+(wid>>2)*32+(lane&3)*8;
  const unsigned kdst=lds0+LDS_K+wid*1024, vdst=lds0+LDS_V+wid*1024;
  #define DMA_K(t,slot) glds16(ksrc+(long)(t)*KVBLK*DM,(unsigned)__builtin_amdgcn_readfirstlane(kdst+(slot)))
  #define DMA_V(t,slot) glds16(vsrc+(long)(t)*KVBLK*DM,(unsigned)__builtin_amdgcn_readfirstlane(vdst+(slot)))
  const int vb0=(int)(lds0+LDS_V)+((lane>>4)&1)*32+(lane&3)*8+(4*hi+((lane&15)>>2))*64;
  const char*Kbase=shm+LDS_K; bf16x8 kf[8];
  const lds_cptr shm3=(lds_cptr)shm; const lds_cptr kp0=shm3+LDS_K+hi*1024+r32*16; const lds_cptr vp0=shm3+LDS_V+((lane>>4)&1)*32+(lane&3)*8+(4*hi+((lane&15)>>2))*64;
  DMA_K(0,0);DMA_V(0,0);DMA_K(1,SLOTB);
  bf16x8 qr[4];
  #pragma unroll
  for(int d0=0;d0<4;++d0)qr[d0]=*reinterpret_cast<const bf16x8*>(&Qw[(long)r32*DM+d0*16+hi*8]);
  float mhat=0.f,l_reg=0.f;f32x16 o[2];o[0]=f32x16{};o[1]=f32x16{};f32x16 negm=f32x16{};asm volatile("":"+v"(negm));
  #define CMASK(P0,P1,t) do{}while(0)
  bool resc=false;
  #define START(P0,P1) do{ const float rm=rowmax(P0,P1); resc=false; \
    { const float dl=rm; mhat=fadd_s(mhat,dl); \
      _Pragma("unroll") for(int r=0;r<16;++r){P0[r]=fsub_s(P0[r],dl);P1[r]=fsub_s(P1[r],dl);} \
      _Pragma("unroll") for(int r=0;r<16;++r)negm[r]=-mhat; asm volatile("":"+v"(negm)); } \
    _Pragma("unroll") for(int r=0;r<16;++r)P0[r]=__builtin_amdgcn_exp2f(P0[r]); }while(0)
  #define RESC() do{ if(resc){ asm volatile("s_waitcnt lgkmcnt(0)":::"memory"); \
      _Pragma("unroll") for(int d_=0;d_<2;++d_) _Pragma("unroll") for(int r=0;r<16;++r)o[d_][r]*=wsf[crow(r,hi)]; } }while(0)
  f32x16 pA0,pA1,pB0,pB1;
  int sl_prev=0,sl_cur=0,sl_next=SLOTB;
  #define ROT() do{sl_prev=sl_cur;sl_cur=sl_next;sl_next=(sl_next==(NSLOT-1)*SLOTB)?0:sl_next+SLOTB;}while(0)
  DMA_K(2,2*SLOTB);
  WAIT_BAR(3);
  qkt(pA0,pA1,Kbase,qr,negm,r32,hi);asm volatile("s_nop 15\n\ts_nop 7":"+v"(pA0),"+v"(pA1));CMASK(pA0,pA1,0);
  START(pA0,pA1);
  _Pragma("unroll") for(int r=0;r<16;++r)pA1[r]=__builtin_amdgcn_exp2f(pA1[r]);
  WAIT_BAR(0);
  DMA_K(3,0);DMA_V(1,SLOTB);
  ROT();
  kload8(kf,kp0+sl_cur);
  WAIT_BAR(2);
  s16x4 vlo[8],vhi[8]; u32x4 pw0,pw1,pw2,pw3;
  #define PKW(P,B) cvtpk_s(P[B],P[B+1])
  #define PAF(k) __builtin_bit_cast(bf16x8,pw##k)
  #define VFR(i) (bf16x8){vlo[i][0],vlo[i][1],vlo[i][2],vlo[i][3],vhi[i][0],vhi[i][1],vhi[i][2],vhi[i][3]}
  #define PIN(x) asm volatile("":"+v"(x))
  #define MX3(a,b,c) __builtin_fmaxf(__builtin_fmaxf((a),(b)),(c))
  #define GAPA(MF,A0,A1,A2,A3,W0,W1,PW) do{ MF; sacc+=A0; sacc+=A1; sacc+=A2; sacc+=A3; PIN(sacc); W0; W1; PIN(PW); SBAR(); }while(0)
  #define EX(v) __builtin_amdgcn_exp2f(v)
  #define GAPB(MF,X,B) do{ MF; X[B]=EX(X[B]); X[B+1]=EX(X[B+1]); X[B+2]=EX(X[B+2]); X[B+3]=EX(X[B+3]); PIN(X); SBAR(); }while(0)
  #define VRD(i) do{ vlo[i]=vtr(vp_+(((i)>>2)*4096+((i)&3)*1024)); vhi[i]=vtr(vp_+(((i)>>2)*4096+((i)&3)*1024+512)); }while(0)
  #define KRD(G,j) do{ if(G){ kload2(kf,kp0+sl_next,j); SBAR(); } }while(0)
  #define STEP(C0,C1,P0,P1,t,GK,GV,GL) do{ SBAR(); \
    const lds_cptr vp_=vp0+sl_prev; \
    VRD(0); SBAR(); float sacc=(P0[0]+P0[1]); \
    GAPA(C0=__builtin_amdgcn_mfma_f32_32x32x16_bf16(kf[0],qr[0],negm,0,0,0), P0[2],P0[3],P0[4],P0[5],     pw0[0]=PKW(P0,0), pw0[1]=PKW(P0,2), pw0); \
    VRD(4); SBAR(); GAPA(C1=__builtin_amdgcn_mfma_f32_32x32x16_bf16(kf[1],qr[0],negm,0,0,0), P0[6],P0[7],P0[8],P0[9],     pw0[2]=PKW(P0,4), pw0[3]=PKW(P0,6), pw0); \
    VRD(1); SBAR(); GAPA(C0=__builtin_amdgcn_mfma_f32_32x32x16_bf16(kf[2],qr[1],C0,0,0,0),   P0[10],P0[11],P0[12],P0[13], pw1[0]=PKW(P0,8), pw1[1]=PKW(P0,10), pw1); \
    VRD(5); SBAR(); GAPA(C1=__builtin_amdgcn_mfma_f32_32x32x16_bf16(kf[3],qr[1],C1,0,0,0),   P0[14],P0[15],P1[0],P1[1],   pw1[2]=PKW(P0,12),pw1[3]=PKW(P0,14), pw1); \
    VRD(2); SBAR(); GAPA(C0=__builtin_amdgcn_mfma_f32_32x32x16_bf16(kf[4],qr[2],C0,0,0,0),   P1[2],P1[3],P1[4],P1[5],     pw2[0]=PKW(P1,0), pw2[1]=PKW(P1,2), pw2); \
    VRD(6); SBAR(); GAPA(C1=__builtin_amdgcn_mfma_f32_32x32x16_bf16(kf[5],qr[2],C1,0,0,0),   P1[6],P1[7],P1[8],P1[9],     pw2[2]=PKW(P1,4), pw2[3]=PKW(P1,6), pw2); \
    VRD(3); SBAR(); GAPA(C0=__builtin_amdgcn_mfma_f32_32x32x16_bf16(kf[6],qr[3],C0,0,0,0),   P1[10],P1[11],P1[12],P1[13], pw3[0]=PKW(P1,8), pw3[1]=PKW(P1,10), pw3); \
    VRD(7); SBAR(); GAPA(C1=__builtin_amdgcn_mfma_f32_32x32x16_bf16(kf[7],qr[3],C1,0,0,0),   P1[14],P1[15],0.f,0.f,       pw3[2]=PKW(P1,12),pw3[3]=PKW(P1,14), pw3); \
    l_reg+=sacc; \
    if(GK){DMA_K((t)+3,sl_cur);} if(GV){DMA_V((t)+1,sl_next);} \
    CMASK(C0,C1,t); \
    { float a=MX3(C0[0],C0[1],C1[0]),b=MX3(C0[2],C0[3],C1[1]); a=MX3(a,C1[2],C1[3]); \
      _Pragma("unroll") for(int r=4;r<16;r+=4){a=MX3(a,C0[r],C0[r+1]);b=MX3(b,C0[r+2],C0[r+3]);a=MX3(a,C1[r],C1[r+1]);b=MX3(b,C1[r+2],C1[r+3]);} \
      float rm=__builtin_fmaxf(a,b); { auto rr=__builtin_amdgcn_permlane32_swap(__float_as_uint(rm),__float_as_uint(rm),false,false); rm=__builtin_fmaxf(__uint_as_float(rr[0]),__uint_as_float(rr[1])); } \
      resc=false; \
      if(__builtin_expect(__any(rm>(float)THRL),0)){ const float dl=__builtin_fmaxf(rm,0.f); mhat+=dl; \
        _Pragma("unroll") for(int r=0;r<16;++r){C0[r]-=dl;C1[r]-=dl;} \
        _Pragma("unroll") for(int r=0;r<16;++r)negm[r]=-mhat; asm volatile("":"+v"(negm)); \
        const float f=__builtin_amdgcn_exp2f(-dl); l_reg*=f; if(hi==0)wsf[r32]=f; resc=true; } } \
    SBAR(); \
    GAPB(o[0]=__builtin_amdgcn_mfma_f32_32x32x16_bf16(PAF(0),VFR(0),o[0],0,0,0), C0,0); \
    GAPB(o[1]=__builtin_amdgcn_mfma_f32_32x32x16_bf16(PAF(0),VFR(4),o[1],0,0,0), C0,4); \
    KRD(GL,0); GAPB(o[0]=__builtin_amdgcn_mfma_f32_32x32x16_bf16(PAF(1),VFR(1),o[0],0,0,0), C0,8); \
    KRD(GL,1); GAPB(o[1]=__builtin_amdgcn_mfma_f32_32x32x16_bf16(PAF(1),VFR(5),o[1],0,0,0), C0,12); \
    KRD(GL,2); GAPB(o[0]=__builtin_amdgcn_mfma_f32_32x32x16_bf16(PAF(2),VFR(2),o[0],0,0,0), C1,0); \
    KRD(GL,3); GAPB(o[1]=__builtin_amdgcn_mfma_f32_32x32x16_bf16(PAF(2),VFR(6),o[1],0,0,0), C1,4); \
    GAPB(o[0]=__builtin_amdgcn_mfma_f32_32x32x16_bf16(PAF(3),VFR(3),o[0],0,0,0), C1,8); \
    GAPB(o[1]=__builtin_amdgcn_mfma_f32_32x32x16_bf16(PAF(3),VFR(7),o[1],0,0,0), C1,12); \
    }while(0)
  int t=1;
  #undef CMASK
  #define CMASK(P0,P1,t) do{}while(0)
  for(;t+5<NT;t+=2){
    STEP(pB0,pB1,pA0,pA1,t,true,true,true);     WAIT_BAR(2); RESC(); ROT();
    STEP(pA0,pA1,pB0,pB1,t+1,true,true,true);   WAIT_BAR(2); RESC(); ROT();
  }
  #undef CMASK
  #define CMASK(P0,P1,t) do{}while(0)
  #define ENDW(tt) do{ if((tt)+3<NT){WAIT_BAR(2);} else if((tt)+2<NT){WAIT_BAR(1);} else {WAIT_BAR(0);} }while(0)
  for(;t+1<NT;t+=2){
    STEP(pB0,pB1,pA0,pA1,t,(t+3<NT),(t+1<NT),(t+1<NT));       ENDW(t);   RESC(); ROT();
    STEP(pA0,pA1,pB0,pB1,t+1,(t+4<NT),(t+2<NT),(t+2<NT));     ENDW(t+1); RESC(); ROT();
  }
  STEP(pB0,pB1,pA0,pA1,NT-1,false,false,false); RESC();
  { float sacc=pB0[0]+pB0[1]; _Pragma("unroll") for(int r=2;r<16;++r)sacc+=pB0[r]; _Pragma("unroll") for(int r=0;r<16;++r)sacc+=pB1[r]; l_reg+=sacc;
    pw0=(u32x4){PKW(pB0,0),PKW(pB0,2),PKW(pB0,4),PKW(pB0,6)};pw1=(u32x4){PKW(pB0,8),PKW(pB0,10),PKW(pB0,12),PKW(pB0,14)};pw2=(u32x4){PKW(pB1,0),PKW(pB1,2),PKW(pB1,4),PKW(pB1,6)};pw3=(u32x4){PKW(pB1,8),PKW(pB1,10),PKW(pB1,12),PKW(pB1,14)};
    SBAR(); pv(o,vb0+sl_cur,PAF(0),PAF(1),PAF(2),PAF(3)); }
  #undef PKW
  #undef PAF
  #undef VFR
  #undef PIN
  #undef MX3
  #undef GAPA
  #undef GAPB
  #undef EX
  #undef VRD
  #undef KRD
  #undef STEP
  #undef ENDW
  {auto rr=__builtin_amdgcn_permlane32_swap(__float_as_uint(l_reg),__float_as_uint(l_reg),false,false);l_reg=__uint_as_float(rr[0])+__uint_as_float(rr[1]);}
  if(hi==0)wsf[32+r32]=l_reg;asm volatile("s_waitcnt lgkmcnt(0)":::"memory");
  float rli[16];
  #pragma unroll
  for(int r=0;r<16;++r)rli[r]=__builtin_amdgcn_rcpf(wsf[32+crow(r,hi)]);
  bf16*Ow=Ou+(long)(wid*QBLK)*DM;
  { bf16*stg=(bf16*)(shm+LDS_OST)+wid*2048;
    #pragma unroll
    for(int r=0;r<16;++r){const int orow=crow(r,hi);
      #pragma unroll
      for(int d0=0;d0<2;++d0)stg[orow*64+d0*32+r32]=__float2bfloat16(o[d0][r]*rli[r]);}
    asm volatile("s_waitcnt lgkmcnt(0)":::"memory");
    #pragma unroll
    for(int i=0;i<4;++i){const int row=i*8+(lane>>3),ch=lane&7; const u32x4 v=*(const u32x4*)(stg+row*64+ch*8); ATTN_STORE16(Ow+(long)row*DM+ch*8,v);} }
  asm volatile("s_waitcnt lgkmcnt(0)\n\ts_barrier":::"memory");
  #undef DMA_K
  #undef DMA_V
  #undef CMASK
  #undef START
  #undef RESC
  #undef ROT
}
constexpr int ATTN_LDS_BYTES=LDS_BYTES;
#undef SBAR
#undef WAIT_BAR
}
#ifndef XB_FENCE_SCOPE
#define XB_FENCE_SCOPE "agent"
#endif
#define GAS __attribute__((address_space(1)))
#define LAS __attribute__((address_space(3)))
typedef unsigned short bf16;
typedef unsigned v4u __attribute__((ext_vector_type(4)));
typedef float f32x4 __attribute__((ext_vector_type(4)));
typedef short bf16x8 __attribute__((ext_vector_type(8)));
typedef GAS unsigned gu32;
typedef GAS unsigned long long gu64;
#define RLX_AGENT __ATOMIC_RELAXED, __HIP_MEMORY_SCOPE_AGENT
#define LDS_WAIT() asm volatile("s_waitcnt lgkmcnt(0)" ::: "memory")
#define VM_WAIT() asm volatile("s_waitcnt vmcnt(0)" ::: "memory")
__device__ __forceinline__ unsigned long long rt() { return __builtin_amdgcn_s_memrealtime(); }
__device__ __forceinline__ unsigned f2bf(float f) { unsigned u = __builtin_bit_cast(unsigned, f); return (u + 0x7fffu + ((u >> 16) & 1u)) >> 16; }
__device__ __forceinline__ unsigned pk2(float lo, float hi) { typedef float pkf2_ __attribute__((ext_vector_type(2))); typedef __bf16 pkb2_ __attribute__((ext_vector_type(2))); const pkf2_ v = {lo, hi}; return __builtin_bit_cast(unsigned, __builtin_convertvector(v, pkb2_)); }

#define XB_TMO      128
#define XB_XCNT(j)  (256  + 64 * (j))
#define XB_XSUB(j)  (1280 + 64 * (j))
#define XB_XGEN(j)  (2304 + 64 * (j))
#define XB_TOP      3328
#define XB_TOPGEN   3392
#define XCD_BAR_WORDS 3456
#define XB_SPIN_CAP (1u << 25)

__device__ __forceinline__ unsigned xb_ld(unsigned* p)              { return __hip_atomic_load(p, __ATOMIC_RELAXED, __HIP_MEMORY_SCOPE_AGENT); }
__device__ __forceinline__ unsigned xb_add(unsigned* p, unsigned v) { return __hip_atomic_fetch_add(p, v, __ATOMIC_RELAXED, __HIP_MEMORY_SCOPE_AGENT); }
__device__ __forceinline__ unsigned xb_xcc_id() { return (unsigned)__builtin_amdgcn_s_getreg((3 << 11) | 20) & 0xFu; }
#define XB_SPIN(cond, bar) do { unsigned _sp = 0; while (cond) { __builtin_amdgcn_s_sleep(1); \
    if ((++_sp & 255u) == 0u) { if (xb_ld(&(bar)[XB_TMO])) break; if (_sp > XB_SPIN_CAP) { atomicAdd(&(bar)[XB_TMO], 1u); break; } } } } while (0)

struct XcdBarrier {
    unsigned* bar; unsigned x;
    volatile LAS unsigned* st;
};

__device__ __forceinline__ XcdBarrier xcd_barrier_post(unsigned* bar, volatile LAS unsigned* st) {
    XcdBarrier b; b.bar = bar; b.x = xb_xcc_id(); b.st = st;
    if (threadIdx.x == 0) (void)xb_add(&bar[XB_XCNT(b.x)], 1u);
    return b;
}
__device__ __forceinline__ void xcd_barrier_complete(unsigned* bar, unsigned x, unsigned& nloc, unsigned& nx) {
    const unsigned G = gridDim.x * gridDim.y * gridDim.z;
    unsigned sum, cnt, mine, sp = 0u;
    for (;;) {
        sum = 0u; cnt = 0u; mine = 0u;
#pragma unroll
        for (unsigned j = 0; j < 16; ++j) { const unsigned c = xb_ld(&bar[XB_XCNT(j)]); sum += c; cnt += (c > 0u) ? 1u : 0u; mine = (j == x) ? c : mine; }
        if (sum == G) break;
        __builtin_amdgcn_s_sleep(1);
        if ((++sp & 255u) == 0u) { if (xb_ld(&bar[XB_TMO])) break; if (sp > XB_SPIN_CAP) { atomicAdd(&bar[XB_TMO], 1u); break; } }
    }
    nloc = mine > 0u ? mine : 1u; nx = cnt > 0u ? cnt : 1u;
}

__device__ __forceinline__ void xcd_barrier(const XcdBarrier& b) {
    asm volatile("s_waitcnt vmcnt(0)" ::: "memory");
    __syncthreads();
    if (threadIdx.x == 0) {
        unsigned* bar = b.bar;
        __builtin_amdgcn_s_waitcnt(0);
        unsigned nloc = b.st[0], nx = b.st[1];
        if (nloc == 0u) { xcd_barrier_complete(bar, b.x, nloc, nx); b.st[0] = nloc; b.st[1] = nx; }
        const unsigned old = xb_add(&bar[XB_XSUB(b.x)], 1u);
        const unsigned gen = old / nloc;
        if (old + 1u == (gen + 1u) * nloc) {
            __builtin_amdgcn_fence(__ATOMIC_RELEASE, XB_FENCE_SCOPE);
            asm volatile("s_waitcnt vmcnt(0)" ::: "memory");
            const unsigned og = xb_add(&bar[XB_TOP], 1u);
            const unsigned tg = og / nx;
            if (og + 1u == (tg + 1u) * nx) xb_add(&bar[XB_TOPGEN], 1u);
            else XB_SPIN(xb_ld(&bar[XB_TOPGEN]) == tg, bar);
            __builtin_amdgcn_fence(__ATOMIC_ACQUIRE, XB_FENCE_SCOPE);
            xb_add(&bar[XB_XGEN(b.x)], 1u);
            asm volatile("s_waitcnt vmcnt(0)" ::: "memory");
        } else {
            XB_SPIN(xb_ld(&bar[XB_XGEN(b.x)]) == gen, bar);
            __builtin_amdgcn_fence(__ATOMIC_ACQUIRE, XB_FENCE_SCOPE);
            asm volatile("s_waitcnt vmcnt(0)" ::: "memory");
        }
    }
    __syncthreads();
}

constexpr size_t MiB = 1u << 20;
constexpr size_t WS_CTL = 0, CTL_ZERO_BYTES = 1 * MiB;
constexpr size_t WS_MOD = 1 * MiB;
constexpr size_t WS_S5A = WS_MOD + 512 * 1024;
constexpr size_t WS_S5B = 2 * MiB;
constexpr size_t WS_ROPE = 3 * MiB;
constexpr size_t WS_WIN = 4 * MiB;
constexpr size_t WS_WGLU = 30 * MiB;
constexpr size_t WS_WBR = 31 * MiB;
constexpr size_t WS_WOUT = 37 * MiB;
constexpr size_t WS_WQ = 41 * MiB;
constexpr size_t WS_TAB = 49 * MiB;
constexpr size_t WS_STRM = 113 * MiB;
constexpr size_t WS_HA = 185 * MiB;
constexpr size_t WS_YDIR = 221 * MiB;
constexpr size_t WS_PROJ = 257 * MiB;
constexpr size_t WS_SC = WS_PROJ, WS_EIDX = WS_PROJ + 144 * MiB, WS_GATE = WS_PROJ + 153 * MiB;
constexpr size_t WS_MLN = 491 * MiB, WS_MLB = 492 * MiB, WS_S5CF = 492 * MiB + 65536, WS_SCT = 492 * MiB + 655360;
constexpr size_t WS_END = 493 * MiB;
static_assert(WS_PROJ + (size_t)MROWS * PW * 2 <= WS_END && WS_END <= 512 * MiB, "ws map");
constexpr int CW_BAR = 4096;
#ifndef SHIFT_N
#define SHIFT_N 0
#endif
#define SHIFT_STR2(x) #x
#define SHIFT_STR(x) SHIFT_STR2(x)
#define SHIFT_HERE() do { if (SHIFT_N > 0) asm volatile(".rept " SHIFT_STR(SHIFT_N) "\n\ts_nop 0\n\t.endr" ::: "memory"); } while (0)
#ifndef SHIFT_POS
#define SHIFT_POS -1
#endif
#ifndef S5_PIN_NOPS
#define S5_PIN_NOPS 0
#endif
#define SHIFT_AT(k) do { if (SHIFT_POS == (k)) asm volatile("s_nop 0"); } while (0)
#ifndef DOUBLE_BAR
#define DOUBLE_BAR 0
#endif

constexpr int RING_BYTES = 131072, LDSCTL_OFF = RING_BYTES, MISC_OFF = LDSCTL_OFF + 320, LDS_BYTES = 147456;
constexpr int NWAVES = 8;
constexpr float ATT_C2 = 0.125f * 1.4426950408889634f;

typedef unsigned u32x2 __attribute__((ext_vector_type(2)));
typedef float f32x2 __attribute__((ext_vector_type(2)));

__device__ __forceinline__ float bf2f(unsigned short u) { return __uint_as_float((unsigned)u << 16); }
__device__ __forceinline__ float bflo(unsigned w) { return __uint_as_float(w << 16); }
__device__ __forceinline__ float bfhi(unsigned w) { return __uint_as_float(w & 0xffff0000u); }
__device__ __forceinline__ float gelu_tanh(float x) { const float u = 1.5957691216057308f * (x + 0.044715f * x * x * x); return x * __builtin_amdgcn_rcpf(1.f + __expf(-u)); }
__device__ __forceinline__ float sigm(float x) { return __builtin_amdgcn_rcpf(1.f + __expf(-x)); }
__device__ __forceinline__ float log_sigmoid(float x) { const float z = __expf(-fabsf(x)); return fminf(x, 0.f) - __logf(1.f + z); }
__device__ __forceinline__ float wave_sum(float v) {
#pragma unroll
    for (int o = 1; o < 64; o <<= 1) v += __shfl_xor(v, o);
    return v;
}
__device__ __forceinline__ int seqmap(int p, int dir) { return dir == 0 ? p : (p < NCTX ? (NCTX - 1 - p) : (SB + NCTX - 1 - p)); }
typedef __bf16 bf16x2_t __attribute__((ext_vector_type(2)));
__device__ __forceinline__ float dot2bf(unsigned a, unsigned b, float c) { return __builtin_amdgcn_fdot2_f32_bf16(__builtin_bit_cast(bf16x2_t, a), __builtin_bit_cast(bf16x2_t, b), c, false); }

struct Args { const float* in[32]; float* out; unsigned char* ws; };
typedef const __attribute__((address_space(4))) Args* KArgsP;
struct Ctx { int tid, lane, wave, vcu, G; LAS unsigned char* lds; unsigned char* ws; };

struct RowOrder {
    pg8::StaticOrder S; int latent;
    __host__ __device__ void init(int latent_, int N, int G_, int c_, int rot = 0) { latent = latent_; S.init(latent_ ? NB * SEQ : MROWS, N, G_, (c_ + G_ - rot % G_) % G_); }
    __host__ __device__ bool next(int i, pg8::Unit& u) const { if (!S.next(i, u)) return false; if (latent) u.pm = 9 * (u.pm >> 3) + 1 + (u.pm & 7); return true; }
    __device__ __forceinline__ void a_ready(const pg8::Unit&) const {}
    __device__ __forceinline__ void done(const pg8::Unit&) const {}
};
struct G1Order {
    pg8::StaticOrder S; int latent, G, c;
    __host__ __device__ void init(int latent_, int G_, int c_) { latent = latent_; G = G_; c = c_; S.init(latent_ ? NB * SEQ : MROWS, PW, G_, c_); }
    __host__ __device__ bool next(int i, pg8::Unit& u) const {
        if (!latent) return S.next(i, u);
        if (S.next(i, u)) { u.pm = 9 * (u.pm >> 3) + 1 + (u.pm & 7); return true; }
        const long L = (long)i * G + c - 1664; if (L < 0 || L >= 64) return false;
        const int w = (int)L & 7; u.pm = 9 * ((int)L >> 3); u.pn = w < 2 ? w : (w == 2 ? 4 : (w < 7 ? w + 4 : 25)); return true;
    }
    __device__ __forceinline__ void a_ready(const pg8::Unit&) const {}
    __device__ __forceinline__ void done(const pg8::Unit&) const {}
};
struct EpiProj {
    static constexpr bool PERM = true, AFTER_DRAIN = false;
    bf16* O;
    __device__ __forceinline__ void operator()(const pg8::f32x4 (&acc)[2][2][4][2], const pg8::Unit& u, int wr, int wc, int fr, int fq) const {
        const int row0 = u.pm * 256 + wr * 64 + fr, col0 = u.pn * 256 + wc * 32 + 8 * fq;
        const bool gate = u.pn >= 13 && u.pn < 25;
#pragma unroll
        for (int ai = 0; ai < 2; ++ai)
#pragma unroll
            for (int m = 0; m < 4; ++m) { bf16* rowp = O + (size_t)(row0 + ai * 128 + m * 16) * PW;
#pragma unroll
                for (int bj = 0; bj < 2; ++bj) { const f32x4 v0 = acc[ai][bj][m][0], v1 = acc[ai][bj][m][1]; const int col = col0 + bj * 128;
                    if (gate) { int w0 = 0, w1 = 0;
                        w0 = __builtin_amdgcn_cvt_pk_fp8_f32(sigm(v0[0]), sigm(v0[1]), w0, false); w0 = __builtin_amdgcn_cvt_pk_fp8_f32(sigm(v0[2]), sigm(v0[3]), w0, true);
                        w1 = __builtin_amdgcn_cvt_pk_fp8_f32(sigm(v1[0]), sigm(v1[1]), w1, false); w1 = __builtin_amdgcn_cvt_pk_fp8_f32(sigm(v1[2]), sigm(v1[3]), w1, true);
                        *(u32x2*)((unsigned char*)(rowp + PC_GL) + (col - PC_GL)) = u32x2{(unsigned)w0, (unsigned)w1};
                    } else { v4u w; w.x = pk2(v0[0], v0[1]); w.y = pk2(v0[2], v0[3]); w.z = pk2(v1[0], v1[1]); w.w = pk2(v1[2], v1[3]); *(v4u*)(rowp + col) = w; } } }
    }
};
struct EpiGlu {
    static constexpr bool PERM = true, AFTER_DRAIN = false;
    const bf16* Y; int ldy; bf16* O; int ldo;
    __device__ __forceinline__ void operator()(const pg8::f32x4 (&acc)[2][2][4][2], const pg8::Unit& u, int wr, int wc, int fr, int fq) const {
        const int row0 = u.pm * 256 + wr * 64 + fr, col0 = u.pn * 256 + wc * 32 + 8 * fq;
#pragma unroll
        for (int ai = 0; ai < 2; ++ai) {
            v4u yv[8];
#pragma unroll
            for (int m = 0; m < 4; ++m)
#pragma unroll
                for (int bj = 0; bj < 2; ++bj) yv[m * 2 + bj] = *(const v4u*)(Y + (size_t)(row0 + ai * 128 + m * 16) * ldy + col0 + bj * 128);
#pragma unroll
            for (int m = 0; m < 4; ++m) { const size_t row = row0 + ai * 128 + m * 16;
#pragma unroll
                for (int bj = 0; bj < 2; ++bj) { const int col = col0 + bj * 128; const v4u y = yv[m * 2 + bj]; const f32x4 v0 = acc[ai][bj][m][0], v1 = acc[ai][bj][m][1];
                    v4u w; w.x = pk2(bflo(y.x) * sigm(v0[0]), bfhi(y.x) * sigm(v0[1])); w.y = pk2(bflo(y.y) * sigm(v0[2]), bfhi(y.y) * sigm(v0[3]));
                    w.z = pk2(bflo(y.z) * sigm(v1[0]), bfhi(y.z) * sigm(v1[1])); w.w = pk2(bflo(y.w) * sigm(v1[2]), bfhi(y.w) * sigm(v1[3]));
                    *(v4u*)(O + row * ldo + col) = w; } } }
    }
};
struct EpiGate {
    static constexpr bool PERM = true, AFTER_DRAIN = false;
    const unsigned char* GL; int ldgb; bf16* O; int ldo; int rmw; const bf16* R;
    __device__ __forceinline__ void operator()(const pg8::f32x4 (&acc)[2][2][4][2], const pg8::Unit& u, int wr, int wc, int fr, int fq) const {
        const int row0 = u.pm * 256 + wr * 64 + fr, col0 = u.pn * 256 + wc * 32 + 8 * fq;
#pragma unroll
        for (int ai = 0; ai < 2; ++ai) {
            u32x2 gq[8]; v4u pq[8];
#pragma unroll
            for (int m = 0; m < 4; ++m)
#pragma unroll
                for (int bj = 0; bj < 2; ++bj) { const size_t row = row0 + ai * 128 + m * 16; const int col = col0 + bj * 128;
                    gq[m * 2 + bj] = *(const u32x2*)(GL + row * ldgb + col); pq[m * 2 + bj] = rmw ? *(const v4u*)(R + row * ldo + col) : v4u{0u, 0u, 0u, 0u}; }
#pragma unroll
            for (int m = 0; m < 4; ++m) { const size_t row = row0 + ai * 128 + m * 16;
#pragma unroll
                for (int bj = 0; bj < 2; ++bj) { const int col = col0 + bj * 128; const u32x2 gv = gq[m * 2 + bj]; const v4u pv = pq[m * 2 + bj]; const f32x4 v0 = acc[ai][bj][m][0], v1 = acc[ai][bj][m][1];
                    const f32x2 ga = __builtin_amdgcn_cvt_pk_f32_fp8((int)gv.x, false), gb = __builtin_amdgcn_cvt_pk_f32_fp8((int)gv.x, true), gc = __builtin_amdgcn_cvt_pk_f32_fp8((int)gv.y, false), gd = __builtin_amdgcn_cvt_pk_f32_fp8((int)gv.y, true);
                    const float o0 = bflo(pv.x) + ga.x * v0[0], o1 = bfhi(pv.x) + ga.y * v0[1], o2 = bflo(pv.y) + gb.x * v0[2], o3 = bfhi(pv.y) + gb.y * v0[3];
                    const float o4 = bflo(pv.z) + gc.x * v1[0], o5 = bfhi(pv.z) + gc.y * v1[1], o6 = bflo(pv.w) + gd.x * v1[2], o7 = bfhi(pv.w) + gd.y * v1[3];
                    v4u w; w.x = pk2(o0, o1); w.y = pk2(o2, o3); w.z = pk2(o4, o5); w.w = pk2(o6, o7);
                    *(v4u*)(O + row * ldo + col) = w; } } }
    }
};
struct EpiResid {
    static constexpr bool PERM = true, AFTER_DRAIN = false;
    bf16* S; const float* modl; int gchunk;
    __device__ __forceinline__ void operator()(const pg8::f32x4 (&acc)[2][2][4][2], const pg8::Unit& u, int wr, int wc, int fr, int fq) const {
        const int b = u.pm / 9; const bool isctx = (u.pm % 9) == 0;
        const float* g = modl + (isctx ? 8 : b) * 6144 + gchunk * 1024;
        const int row0 = u.pm * 256 + wr * 64 + fr, col0 = u.pn * 256 + wc * 32 + 8 * fq;
        f32x4 g0[2], g1[2];
#pragma unroll
        for (int bj = 0; bj < 2; ++bj) { g0[bj] = *(const f32x4*)(g + col0 + bj * 128); g1[bj] = *(const f32x4*)(g + col0 + bj * 128 + 4); }
#pragma unroll
        for (int ai = 0; ai < 2; ++ai) {
            v4u sq[8];
#pragma unroll
            for (int m = 0; m < 4; ++m)
#pragma unroll
                for (int bj = 0; bj < 2; ++bj) sq[m * 2 + bj] = *(const v4u*)(S + (size_t)(row0 + ai * 128 + m * 16) * DM_ + col0 + bj * 128);
#pragma unroll
            for (int m = 0; m < 4; ++m)
#pragma unroll
                for (int bj = 0; bj < 2; ++bj) { bf16* p = S + (size_t)(row0 + ai * 128 + m * 16) * DM_ + col0 + bj * 128; const v4u o = sq[m * 2 + bj]; const f32x4 a0 = acc[ai][bj][m][0], a1 = acc[ai][bj][m][1];
                    v4u w; w.x = pk2(bflo(o.x) + g0[bj][0] * a0[0], bfhi(o.x) + g0[bj][1] * a0[1]); w.y = pk2(bflo(o.y) + g0[bj][2] * a0[2], bfhi(o.y) + g0[bj][3] * a0[3]);
                    w.z = pk2(bflo(o.z) + g1[bj][0] * a1[0], bfhi(o.z) + g1[bj][1] * a1[1]); w.w = pk2(bflo(o.w) + g1[bj][2] * a1[2], bfhi(o.w) + g1[bj][3] * a1[3]); *(v4u*)p = w; } }
    }
};
struct EpiF32 {
    static constexpr bool PERM = false, AFTER_DRAIN = false;
    float* O; int ldo;
    __device__ __forceinline__ void operator()(const pg8::f32x4 (&acc)[2][2][4][2], const pg8::Unit& u, int wr, int wc, int fr, int fq) const {
        const int row0 = u.pm * 256 + wr * 64 + fr, col0 = u.pn * 256 + wc * 32 + 4 * fq;
#pragma unroll
        for (int ai = 0; ai < 2; ++ai)
#pragma unroll
            for (int m = 0; m < 4; ++m)
#pragma unroll
                for (int bj = 0; bj < 2; ++bj)
#pragma unroll
                    for (int n = 0; n < 2; ++n) *(f32x4*)(O + (size_t)(row0 + ai * 128 + m * 16) * ldo + col0 + bj * 128 + n * 16) = acc[ai][bj][m][n];
    }
};

__device__ __forceinline__ void transpose_item(const float* W, int K, int N, bf16* WT, int k0, int n0, int ns0, int nvalid, LAS float* scr, int lane) {
    float tv_[32];
#pragma unroll
    for (int i = 0; i < 32; ++i) { const int kk = 2 * i + (lane >> 5); const int c = lane & 31; tv_[i] = c < nvalid ? W[(size_t)(k0 + kk) * N + ns0 + c] : 0.f; }
#pragma unroll
    for (int i = 0; i < 32; ++i) { const int kk = 2 * i + (lane >> 5); const int c = lane & 31; scr[kk * 33 + c] = tv_[i]; }
    LDS_WAIT(); asm volatile("" ::: "memory");
    const int c = lane & 7;
#pragma unroll
    for (int j = 0; j < 4; ++j) { const int n = (lane >> 3) + 8 * j; const LAS float* s = scr + (8 * c) * 33 + n;
        v4u o; o.x = pk2(s[0 * 33], s[1 * 33]); o.y = pk2(s[2 * 33], s[3 * 33]); o.z = pk2(s[4 * 33], s[5 * 33]); o.w = pk2(s[6 * 33], s[7 * 33]);
        *(GAS v4u*)(WT + (size_t)(n0 + n) * K + k0 + 8 * c) = o; }
    LDS_WAIT(); asm volatile("" ::: "memory");
}
__device__ __forceinline__ void transpose_plain(const float* W, int K, int N, bf16* WT, int item, LAS float* scr, int lane) {
    const int nblk = N / 32, kb = item / nblk, nb = item % nblk;
    transpose_item(W, K, N, WT, 64 * kb, 32 * nb, 32 * nb, 32, scr, lane);
}
__device__ __forceinline__ void transpose_win(const float* W, bf16* WT, int item, LAS float* scr, int lane) {
    const int nblk = PW / 32, kb = item / nblk, nb = item % nblk, n0 = 32 * nb;
    int ns0, nv;
    if (n0 < PC_GL) { ns0 = n0; nv = 32; } else if (n0 < PC_GM) { ns0 = n0 + 16; nv = 32; } else if (n0 == PC_GM) { ns0 = 3328; nv = 16; } else { ns0 = 0; nv = 0; }
    transpose_item(W, DM_, INW, WT, 64 * kb, n0, ns0, nv, scr, lane);
}
__device__ __forceinline__ void convert_stream(const float* src, bf16* dst, size_t n, size_t gtid, size_t nthr) {
    for (size_t i = gtid; i < n / 8; i += nthr) { const f32x4 a = ((const f32x4*)src)[2 * i], b = ((const f32x4*)src)[2 * i + 1];
        v4u o; o.x = pk2(a[0], a[1]); o.y = pk2(a[2], a[3]); o.z = pk2(b[0], b[1]); o.w = pk2(b[2], b[3]); ((v4u*)dst)[i] = o; }
}

__device__ __forceinline__ void convert_stream_fp8(const float* src, unsigned char* dst, size_t n, float scale, size_t gtid, size_t nthr) {
    for (size_t i = gtid; i < n / 16; i += nthr) { const f32x4 a = ((const f32x4*)src)[4 * i] * scale, b = ((const f32x4*)src)[4 * i + 1] * scale, c = ((const f32x4*)src)[4 * i + 2] * scale, d = ((const f32x4*)src)[4 * i + 3] * scale;
        v4u o; int w;
        w = __builtin_amdgcn_cvt_pk_fp8_f32(a[0], a[1], 0, false); w = __builtin_amdgcn_cvt_pk_fp8_f32(a[2], a[3], w, true); o.x = (unsigned)w;
        w = __builtin_amdgcn_cvt_pk_fp8_f32(b[0], b[1], 0, false); w = __builtin_amdgcn_cvt_pk_fp8_f32(b[2], b[3], w, true); o.y = (unsigned)w;
        w = __builtin_amdgcn_cvt_pk_fp8_f32(c[0], c[1], 0, false); w = __builtin_amdgcn_cvt_pk_fp8_f32(c[2], c[3], w, true); o.z = (unsigned)w;
        w = __builtin_amdgcn_cvt_pk_fp8_f32(d[0], d[1], 0, false); w = __builtin_amdgcn_cvt_pk_fp8_f32(d[2], d[3], w, true); o.w = (unsigned)w;
        *(v4u*)(dst + (i >> 6) * 2048 + (i & 63) * 16) = o; }
}
typedef unsigned v6u __attribute__((ext_vector_type(6)));
typedef float v16f __attribute__((ext_vector_type(16)));
typedef float v32f __attribute__((ext_vector_type(32)));
constexpr int F6_REC = 1536;
#ifndef F6_INTERLEAVED
#define F6_INTERLEAVED 1
#endif
__device__ __forceinline__ constexpr int f6_dim(int j) { return F6_INTERLEAVED ? ((j & 1) ? 16 + (j >> 1) : (j >> 1)) : j; }
__device__ __forceinline__ void convert_rows_fp6(const float* pu, const float* pv, unsigned char* tab, float2* sct, size_t gt, size_t nt) {
    const int lane = (int)(gt & 63), L = lane & 31; const size_t w0 = gt >> 6, nw = nt >> 6;
    for (size_t rp = w0; rp < 8192; rp += nw) {
        const size_t e = 2 * rp + (lane >> 5);
        float sc[2];
#pragma unroll
        for (int uv = 0; uv < 2; ++uv) {
            const f32x4* src = (const f32x4*)((uv ? pv : pu) + e * 1024 + 32 * L);
            f32x4 a[8];
#pragma unroll
            for (int i = 0; i < 8; ++i) a[i] = src[i];
            float mx = 0.f;
#pragma unroll
            for (int i = 0; i < 8; ++i) mx = fmaxf(fmaxf(mx, fmaxf(fabsf(a[i][0]), fabsf(a[i][1]))), fmaxf(fabsf(a[i][2]), fabsf(a[i][3])));
            mx = fmaxf(mx, __shfl_xor(mx, 1)); mx = fmaxf(mx, __shfl_xor(mx, 2)); mx = fmaxf(mx, __shfl_xor(mx, 4)); mx = fmaxf(mx, __shfl_xor(mx, 8)); mx = fmaxf(mx, __shfl_xor(mx, 16));
            const float s = fmaxf(mx, 1e-30f) * (1.f / 7.5f), inv = 1.f / s; sc[uv] = s;
            v16f lo, hi;
#pragma unroll
            for (int i = 0; i < 16; ++i) { lo[i] = a[i >> 2][i & 3] * inv; hi[i] = a[4 + (i >> 2)][i & 3] * inv; }
            const v6u w = __builtin_amdgcn_cvt_scalef32_2xpk16_fp6_f32(lo, hi, 1.f);
#ifdef F6_DIAG
            if (rp == 0 && uv == 0) {
                const v32f dec = __builtin_amdgcn_cvt_scalef32_pk32_f32_fp6(w, 1.f);
                typedef __bf16 bf32d_t __attribute__((ext_vector_type(32))); typedef unsigned v16ud_t __attribute__((ext_vector_type(16)));
                const v16ud_t db = __builtin_bit_cast(v16ud_t, __builtin_amdgcn_cvt_scalef32_pk32_bf16_fp6(w, 1.f));
                float eA = 0.f, eB = 0.f, eC = 0.f;
#pragma unroll
                for (int j = 0; j < 32; ++j) { eA = fmaxf(eA, fabsf(dec[j] - ((j & 1) ? hi[j >> 1] : lo[j >> 1]))); eB = fmaxf(eB, fabsf(dec[j] - (j < 16 ? lo[j] : hi[j - 16])));
                    const float bj = (j & 1) ? __uint_as_float(db[j >> 1] & 0xffff0000u) : __uint_as_float(db[j >> 1] << 16); eC = fmaxf(eC, fabsf(bj - dec[j])); }
#pragma unroll
                for (int o = 1; o < 64; o <<= 1) { eA = fmaxf(eA, __shfl_xor(eA, o)); eB = fmaxf(eB, __shfl_xor(eB, o)); eC = fmaxf(eC, __shfl_xor(eC, o)); }
                if (lane == 0) { float* dg = (float*)sct + 2 * 32768; dg[0] = eA; dg[1] = eB; dg[2] = eC; }
            }
#endif
            unsigned char* rec = tab + e * F6_REC + uv * 768;
            *(v4u*)(rec + L * 16) = v4u{w[0], w[1], w[2], w[3]}; *(u32x2*)(rec + 512 + L * 8) = u32x2{w[4], w[5]};
        }
        if (L == 0) sct[e] = make_float2(sc[0], sc[1]);
    }
}
#ifdef PEER_FP4
constexpr int F4_REC = 1024;
__device__ __forceinline__ void convert_rows_fp4(const float* pu, const float* pv, unsigned char* tab, float2* sct, size_t gt, size_t nt) {
    const int lane = (int)(gt & 63), L = lane & 31; const size_t w0 = gt >> 6, nw = nt >> 6;
    for (size_t rp = w0; rp < 8192; rp += nw) {
        const size_t e = 2 * rp + (lane >> 5);
        float sc[2];
#pragma unroll
        for (int uv = 0; uv < 2; ++uv) {
            const f32x4* src = (const f32x4*)((uv ? pv : pu) + e * 1024 + 32 * L);
            f32x4 a[8];
#pragma unroll
            for (int i = 0; i < 8; ++i) a[i] = src[i];
            float mx = 0.f;
#pragma unroll
            for (int i = 0; i < 8; ++i) mx = fmaxf(fmaxf(mx, fmaxf(fabsf(a[i][0]), fabsf(a[i][1]))), fmaxf(fabsf(a[i][2]), fabsf(a[i][3])));
            mx = fmaxf(mx, __shfl_xor(mx, 1)); mx = fmaxf(mx, __shfl_xor(mx, 2)); mx = fmaxf(mx, __shfl_xor(mx, 4)); mx = fmaxf(mx, __shfl_xor(mx, 8)); mx = fmaxf(mx, __shfl_xor(mx, 16));
            const float s = fmaxf(mx, 1e-30f) * (1.f / 6.f), inv = 1.f / s; sc[uv] = s;
            unsigned w[4];
#pragma unroll
            for (int d = 0; d < 4; ++d) { unsigned t = 0u;
                t = __builtin_amdgcn_cvt_scalef32_pk_fp4_f32(t, a[2 * d][0] * inv, a[2 * d][1] * inv, 1.f, 0); t = __builtin_amdgcn_cvt_scalef32_pk_fp4_f32(t, a[2 * d][2] * inv, a[2 * d][3] * inv, 1.f, 1);
                t = __builtin_amdgcn_cvt_scalef32_pk_fp4_f32(t, a[2 * d + 1][0] * inv, a[2 * d + 1][1] * inv, 1.f, 2); t = __builtin_amdgcn_cvt_scalef32_pk_fp4_f32(t, a[2 * d + 1][2] * inv, a[2 * d + 1][3] * inv, 1.f, 3); w[d] = t; }
            *(v4u*)(tab + e * F4_REC + uv * 512 + L * 16) = v4u{w[0], w[1], w[2], w[3]};
        }
        if (L == 0) sct[e] = make_float2(sc[0], sc[1]);
    }
}
#define convert_rows_peer convert_rows_fp4
constexpr int PEER_REC = F4_REC;
#else
#define convert_rows_peer convert_rows_fp6
constexpr int PEER_REC = F6_REC;
#endif
constexpr float USCALE = 64.f;
template <bool SRC_BF16>
__device__ __forceinline__ void norm_row(const void* src, bf16* copy_to, const float* gamma, const float* modr, int sh_chunk, int sc_chunk, bf16* orow, int lane) {
    f32x4 v[4]; float ss = 0.f;
#pragma unroll
    for (int j = 0; j < 4; ++j) {
        if constexpr (SRC_BF16) { const u32x2 w = ((const u32x2*)src)[lane + 64 * j]; v[j] = f32x4{bflo(w.x), bfhi(w.x), bflo(w.y), bfhi(w.y)}; }
        else v[j] = ((const f32x4*)src)[lane + 64 * j];
        ss += v[j][0] * v[j][0] + v[j][1] * v[j][1] + v[j][2] * v[j][2] + v[j][3] * v[j][3]; }
    if (copy_to) {
#pragma unroll
        for (int j = 0; j < 4; ++j) { u32x2 w; w.x = pk2(v[j][0], v[j][1]); w.y = pk2(v[j][2], v[j][3]); ((u32x2*)copy_to)[lane + 64 * j] = w;
            v[j] = f32x4{bflo(w.x), bfhi(w.x), bflo(w.y), bfhi(w.y)}; }
        ss = 0.f;
#pragma unroll
        for (int j = 0; j < 4; ++j) ss += v[j][0] * v[j][0] + v[j][1] * v[j][1] + v[j][2] * v[j][2] + v[j][3] * v[j][3]; }
    const float r = rsqrtf(wave_sum(ss) * (1.f / DM_) + EPS_);
#pragma unroll
    for (int j = 0; j < 4; ++j) { const int c = 4 * (lane + 64 * j);
        const f32x4 g = *(const f32x4*)(gamma + c), sc = *(const f32x4*)(modr + sc_chunk * 1024 + c), sh = *(const f32x4*)(modr + sh_chunk * 1024 + c);
        const f32x4 o = v[j] * r * g * (sc + 1.f) + sh;
        u32x2 w; w.x = pk2(o[0], o[1]); w.y = pk2(o[2], o[3]); *(u32x2*)(orow + c) = w; }
}

namespace ml {
typedef short bf16x8 __attribute__((ext_vector_type(8)));
typedef float f32x16 __attribute__((ext_vector_type(16)));
constexpr float KSCALE = 0.08838834764831845f;
constexpr int NCH = 18;
__device__ __forceinline__ int toff(int R, int C) { return R * 256 + ((((C) >> 3) ^ (R & 15)) << 4) + ((C & 7) << 1); }
__device__ __forceinline__ int crow(int reg, int h) { return (reg & 3) + 8 * (reg >> 2) + 4 * h; }
__device__ __forceinline__ unsigned cvtpk(float lo, float hi) { typedef float f2 __attribute__((ext_vector_type(2))); typedef __bf16 b2 __attribute__((ext_vector_type(2))); f2 v = {lo, hi}; b2 b = __builtin_convertvector(v, b2); return __builtin_bit_cast(unsigned, b); }
__device__ __forceinline__ bf16x8 pack8(float a0, float a1, float a2, float a3, float a4, float a5, float a6, float a7) {
    v4u w; w.x = cvtpk(a0, a1); w.y = cvtpk(a2, a3); w.z = cvtpk(a4, a5); w.w = cvtpk(a6, a7); return __builtin_bit_cast(bf16x8, w); }
__device__ __forceinline__ int chunk_tok(int c, int j, int dir) { return seqmap(128 * c + j, dir); }

__device__ __forceinline__ void gate_tables(LAS float* tab, const bf16* projb, const float* gb, int h, int dir, int c, int tid) {
    if (tid < 128) { const bf16* pr = projb + (size_t)chunk_tok(c, tid, dir) * PW + PC_GM + dir * 8 + h;
        tab[256 + tid] = bf2f(pr[0]) + gb[dir * 8 + h]; tab[tid] = log_sigmoid(bf2f(pr[4]) + gb[dir * 8 + 4 + h]); }
    float sc = 0.f;
    if (tid < 128) { sc = tab[tid]; const int ln = tid & 63;
#pragma unroll
        for (int o = 1; o < 64; o <<= 1) { const float up = __shfl_up(sc, o); if (ln >= o) sc += up; }
        if (tid == 63) tab[1023] = sc; }
    __syncthreads();
    if (tid < 128) tab[128 + tid] = sc + (tid >= 64 ? tab[1023] : 0.f);
    __syncthreads();
}
__device__ __forceinline__ void stage_T(LAS unsigned char* T, const bf16* src  , int c, int dir, const LAS float* scale, int lane, int wave) {
#pragma unroll
    for (int it = 0; it < 4; ++it) { const int s = lane + 64 * (it & 1), cc = wave + 8 * (it >> 1);
        const v4u v = *(const v4u*)(src + (size_t)chunk_tok(c, s, dir) * PW + cc * 8);
        const unsigned wd[4] = {v.x, v.y, v.z, v.w};
        if (scale) { const float w = scale[s];
#pragma unroll
            for (int i = 0; i < 4; ++i) { const unsigned p = cvtpk(bflo(wd[i]) * w, bfhi(wd[i]) * w);
                *(LAS unsigned short*)(T + toff(cc * 8 + 2 * i, s)) = (unsigned short)(p & 0xffffu); *(LAS unsigned short*)(T + toff(cc * 8 + 2 * i + 1, s)) = (unsigned short)(p >> 16); }
        } else {
#pragma unroll
            for (int i = 0; i < 4; ++i) { *(LAS unsigned short*)(T + toff(cc * 8 + 2 * i, s)) = (unsigned short)(wd[i] & 0xffffu); *(LAS unsigned short*)(T + toff(cc * 8 + 2 * i + 1, s)) = (unsigned short)(wd[i] >> 16); }
        } }
}
__device__ __forceinline__ void stage_N(LAS unsigned char* T, const bf16* src, int c, int dir, const LAS float* scale, int tid) {
#pragma unroll
    for (int it = 0; it < 4; ++it) { const int id = tid + 512 * it, row = id >> 4, ch = id & 15;
        v4u v = *(const v4u*)(src + (size_t)chunk_tok(c, row, dir) * PW + ch * 8);
        if (scale) { const float w = scale[row]; v.x = cvtpk(bflo(v.x) * w, bfhi(v.x) * w); v.y = cvtpk(bflo(v.y) * w, bfhi(v.y) * w); v.z = cvtpk(bflo(v.z) * w, bfhi(v.z) * w); v.w = cvtpk(bflo(v.w) * w, bfhi(v.w) * w); }
        *(LAS v4u*)(T + toff(row, ch * 8)) = v; }
}

__device__ __forceinline__ void m1_unit(LAS unsigned char* L, const bf16* projb, const float* gb, int h, int dir, int c, bf16* Uout, float* nout, float* Bout) {
    int tid = threadIdx.x; asm volatile("" : "+v"(tid)); const int lane = tid & 63, wave = __builtin_amdgcn_readfirstlane(tid >> 6), r = lane & 31, hh = lane >> 5;
    LAS unsigned char* TV = L; LAS unsigned char* TK = L + 32768; LAS float* tab = (LAS float*)(L + 65536);
    gate_tables(tab, projb, gb, h, dir, c, tid);
    if (tid < 128) tab[384 + tid] = KSCALE * __expf(fminf(tab[128 + 127] - tab[128 + tid] + tab[256 + tid], 80.f));
    __syncthreads();
    stage_T(TV, projb + PC_VM + h * 128, c, dir, tab + 384, lane, wave);
    stage_T(TK, projb + PC_KM + h * 128, c, dir, nullptr, lane, wave);
    __syncthreads();
    const int vt = wave >> 1, dt0 = (wave & 1) * 2;
    f32x16 acc0 = {}, acc1 = {};
#pragma unroll
    for (int ks = 0; ks < 8; ++ks) {
        const bf16x8 a = *(const LAS bf16x8*)(TV + toff(32 * vt + r, 16 * ks + 8 * hh));
        const bf16x8 b0 = *(const LAS bf16x8*)(TK + toff(32 * dt0 + r, 16 * ks + 8 * hh)), b1 = *(const LAS bf16x8*)(TK + toff(32 * dt0 + 32 + r, 16 * ks + 8 * hh));
        acc0 = __builtin_amdgcn_mfma_f32_32x32x16_bf16(a, b0, acc0, 0, 0, 0); acc1 = __builtin_amdgcn_mfma_f32_32x32x16_bf16(a, b1, acc1, 0, 0, 0);
    }
#pragma unroll
    for (int reg = 0; reg < 16; reg += 2) { const int v = 32 * vt + crow(reg, hh); const unsigned w0 = cvtpk(acc0[reg], acc0[reg + 1]), w1 = cvtpk(acc1[reg], acc1[reg + 1]);
        unsigned short* up = (unsigned short*)Uout + v * 128 + 32 * dt0 + r;
        up[0] = (unsigned short)(w0 & 0xffffu); up[128] = (unsigned short)(w0 >> 16); up[32] = (unsigned short)(w1 & 0xffffu); up[160] = (unsigned short)(w1 >> 16); }
    {   const int d = tid & 127, part = tid >> 7; float a = 0.f;
#pragma unroll
        for (int j = 0; j < 4; ++j) { const int s0 = part * 32 + 8 * j; const v4u k8 = *(const LAS v4u*)(TK + toff(d, s0)); const LAS float* w = tab + 384 + s0;
            a += bflo(k8.x) * w[0] + bfhi(k8.x) * w[1] + bflo(k8.y) * w[2] + bfhi(k8.y) * w[3] + bflo(k8.z) * w[4] + bfhi(k8.z) * w[5] + bflo(k8.w) * w[6] + bfhi(k8.w) * w[7]; }
        tab[512 + part * 128 + d] = a; }
    __syncthreads();
    if (tid < 128) nout[tid] = (tab[512 + tid] + tab[640 + tid]) + (tab[768 + tid] + tab[896 + tid]);
    if (tid == 0) Bout[0] = tab[128 + 127];
    __syncthreads();
}

__device__ __forceinline__ void m3_dir(LAS unsigned char* L, const bf16* projb, const float* gb, int h, int dir, int c, const bf16* Udir  , const float* ndir  , const float* Bdir  , f32x16 (&hout)[2]) {
    int tid = threadIdx.x; asm volatile("" : "+v"(tid)); const int lane = tid & 63, wave = __builtin_amdgcn_readfirstlane(tid >> 6), r = lane & 31, hh = lane >> 5;
    LAS unsigned char* TQ = L; LAS unsigned char* TK = L + 32768; LAS unsigned char* TVT = L + 65536; LAS unsigned char* TC = L + 98304;
    LAS float* tab = (LAS float*)(L + 131072 + 1024);
    gate_tables(tab, projb, gb, h, dir, c, tid);
    if (tid < 128) { tab[384 + tid] = __expf(tab[128 + tid]); tab[512 + tid] = KSCALE * __expf(fminf(tab[256 + tid] - tab[128 + tid], 80.f)); }
    {
        float cs[32]; float ns = 0.f;
#pragma unroll
        for (int i = 0; i < 32; ++i) cs[i] = 0.f;
#pragma unroll 4
        for (int cp = 0; cp < c; ++cp) {
            const float dec = __expf(Bdir[cp]);
            const v4u* up = (const v4u*)(Udir + (size_t)cp * 16384 + tid * 32);
            const v4u u0 = up[0], u1 = up[1], u2 = up[2], u3 = up[3];
            const unsigned wd[16] = {u0.x, u0.y, u0.z, u0.w, u1.x, u1.y, u1.z, u1.w, u2.x, u2.y, u2.z, u2.w, u3.x, u3.y, u3.z, u3.w};
#pragma unroll
            for (int i = 0; i < 16; ++i) { cs[2 * i] = cs[2 * i] * dec + bflo(wd[i]); cs[2 * i + 1] = cs[2 * i + 1] * dec + bfhi(wd[i]); }
            if (tid < 128) ns = ns * dec + ndir[cp * 128 + tid];
        }
        const int v = tid >> 2, d0 = (tid & 3) * 32;
#pragma unroll
        for (int q = 0; q < 4; ++q) { v4u w; w.x = cvtpk(cs[8 * q], cs[8 * q + 1]); w.y = cvtpk(cs[8 * q + 2], cs[8 * q + 3]); w.z = cvtpk(cs[8 * q + 4], cs[8 * q + 5]); w.w = cvtpk(cs[8 * q + 6], cs[8 * q + 7]);
            *(LAS v4u*)(TC + toff(v, d0 + 8 * q)) = w; }
        if (tid < 128) tab[640 + tid] = ns;
    }
    __syncthreads();
    stage_N(TQ, projb + PC_QM + h * 128, c, dir, tab + 384, tid);
    stage_N(TK, projb + PC_KM + h * 128, c, dir, nullptr, tid);
    stage_T(TVT, projb + PC_VM + h * 128, c, dir, nullptr, lane, wave);
    __syncthreads();
    const int jt = wave & 3, vh = wave >> 2;
    bf16x8 qf[8];
#pragma unroll
    for (int ks = 0; ks < 8; ++ks) qf[ks] = *(const LAS bf16x8*)(TQ + toff(32 * jt + r, 16 * ks + 8 * hh));
    f32x16 num0 = {}, num1 = {}; float dsum = 0.f;
    const int jpos = 32 * jt + r;
    for (int st = 0; st <= jt; ++st) {
        f32x16 acc = {};
#pragma unroll
        for (int ks = 0; ks < 8; ++ks) { const bf16x8 kf = *(const LAS bf16x8*)(TK + toff(32 * st + r, 16 * ks + 8 * hh)); acc = __builtin_amdgcn_mfma_f32_32x32x16_bf16(kf, qf[ks], acc, 0, 0, 0); }
#pragma unroll
        for (int reg = 0; reg < 16; ++reg) { const int s = 32 * st + crow(reg, hh); float v = acc[reg] * tab[512 + s]; if (s > jpos) v = 0.f; acc[reg] = v; dsum += v; }
#pragma unroll
        for (int k2 = 0; k2 < 2; ++k2) {
            const bf16x8 pf = pack8(acc[8 * k2], acc[8 * k2 + 1], acc[8 * k2 + 2], acc[8 * k2 + 3], acc[8 * k2 + 4], acc[8 * k2 + 5], acc[8 * k2 + 6], acc[8 * k2 + 7]);
            const int g = 2 * st + k2;
#pragma unroll
            for (int t = 0; t < 2; ++t) { const int vr = 32 * (2 * vh + t) + r;
                const u32x2 lo = *(const LAS u32x2*)(TVT + vr * 256 + (((2 * g) ^ (vr & 15)) << 4) + 8 * hh), hi = *(const LAS u32x2*)(TVT + vr * 256 + (((2 * g + 1) ^ (vr & 15)) << 4) + 8 * hh);
                v4u bw; bw.x = lo.x; bw.y = lo.y; bw.z = hi.x; bw.w = hi.y; const bf16x8 bfv = __builtin_bit_cast(bf16x8, bw);
                if (t == 0) num0 = __builtin_amdgcn_mfma_f32_32x32x16_bf16(pf, bfv, num0, 0, 0, 0); else num1 = __builtin_amdgcn_mfma_f32_32x32x16_bf16(pf, bfv, num1, 0, 0, 0); }
        }
    }
#pragma unroll
    for (int ks = 0; ks < 8; ++ks) {
        const bf16x8 c0 = *(const LAS bf16x8*)(TC + toff(32 * (2 * vh) + r, 16 * ks + 8 * hh)), c1 = *(const LAS bf16x8*)(TC + toff(32 * (2 * vh + 1) + r, 16 * ks + 8 * hh));
        num0 = __builtin_amdgcn_mfma_f32_32x32x16_bf16(qf[ks], c0, num0, 0, 0, 0); num1 = __builtin_amdgcn_mfma_f32_32x32x16_bf16(qf[ks], c1, num1, 0, 0, 0);
    }
    float qn = 0.f;
#pragma unroll
    for (int ch = 0; ch < 8; ++ch) { const v4u q8 = *(const LAS v4u*)(TQ + toff(jpos, 64 * hh + 8 * ch)); const LAS float* np = tab + 640 + 64 * hh + 8 * ch;
        qn += bflo(q8.x) * np[0] + bfhi(q8.x) * np[1] + bflo(q8.y) * np[2] + bfhi(q8.y) * np[3] + bflo(q8.z) * np[4] + bfhi(q8.z) * np[5] + bflo(q8.w) * np[6] + bfhi(q8.w) * np[7]; }
    float den = dsum + qn; den += __shfl_xor(den, 32);
    LAS float* dt = tab + 768 + wave * 32;
    if (hh == 0) dt[r] = den;
    LDS_WAIT(); asm volatile("" ::: "memory");
#pragma unroll
    for (int reg = 0; reg < 16; ++reg) { const float sc = __builtin_amdgcn_rcpf(fmaxf(fabsf(dt[crow(reg, hh)]), 1.f)); hout[0][reg] = num0[reg] * sc; hout[1][reg] = num1[reg] * sc; }
    __syncthreads();
}

__device__ __forceinline__ void m3_unit(LAS unsigned char* L, bf16* projb, const float* gb, const float* ng  , int h, int jc, const bf16* Ubh  , const float* nbh  , const float* Bbh  ) {
    f32x16 hf[2], hb[2];
    m3_dir(L, projb, gb, h, 0, jc, Ubh, nbh, Bbh, hf);
    const int cb = jc < 2 ? 1 - jc : 19 - jc;
    m3_dir(L, projb, gb, h, 1, cb, Ubh + (size_t)NCH * 16384, nbh + NCH * 128, Bbh + NCH, hb);
    int tid = threadIdx.x; asm volatile("" : "+v"(tid)); const int lane = tid & 63, wave = __builtin_amdgcn_readfirstlane(tid >> 6), r = lane & 31, hh = lane >> 5, jt = wave & 3, vh = wave >> 2;
    LAS float* hs = (LAS float*)L;
#pragma unroll
    for (int t = 0; t < 2; ++t)
#pragma unroll
        for (int reg = 0; reg < 16; ++reg) hs[(32 * jt + crow(reg, hh)) * 128 + 32 * (2 * vh + t) + r] = hf[t][reg];
    __syncthreads();
#pragma unroll
    for (int t = 0; t < 2; ++t)
#pragma unroll
        for (int reg = 0; reg < 16; ++reg) hs[(127 - (32 * jt + crow(reg, hh))) * 128 + 32 * (2 * vh + t) + r] += hb[t][reg];
    __syncthreads();
    {   const int row = tid >> 2, q = tid & 3; const LAS f32x4* hp = (const LAS f32x4*)(hs + row * 128 + q * 32);
        f32x4 x[8]; float ss = 0.f;
#pragma unroll
        for (int i = 0; i < 8; ++i) { x[i] = hp[i]; ss += x[i][0] * x[i][0] + x[i][1] * x[i][1] + x[i][2] * x[i][2] + x[i][3] * x[i][3]; }
        ss += __shfl_xor(ss, 1); ss += __shfl_xor(ss, 2);
        const float rs = rsqrtf(ss * (1.f / 128.f) + EPS_);
        bf16* pr = projb + (size_t)(128 * jc + row) * PW;
#pragma unroll
        for (int i = 0; i < 4; ++i) { const v4u ov = *(const v4u*)(pr + PC_OM + h * 128 + q * 32 + 8 * i); const f32x4 g0 = *(const f32x4*)(ng + q * 32 + 8 * i), g1 = *(const f32x4*)(ng + q * 32 + 8 * i + 4);
            const f32x4 a = x[2 * i] * rs * g0, b = x[2 * i + 1] * rs * g1;
            v4u w; w.x = cvtpk(a[0] * sigm(bflo(ov.x)), a[1] * sigm(bfhi(ov.x))); w.y = cvtpk(a[2] * sigm(bflo(ov.y)), a[3] * sigm(bfhi(ov.y)));
            w.z = cvtpk(b[0] * sigm(bflo(ov.z)), b[1] * sigm(bfhi(ov.z))); w.w = cvtpk(b[2] * sigm(bflo(ov.w)), b[3] * sigm(bfhi(ov.w)));
            *(v4u*)(pr + PC_QM + h * 128 + q * 32 + 8 * i) = w; }
    }
    __syncthreads();
}
}

namespace s5 {
typedef short bf16x8 __attribute__((ext_vector_type(8)));
typedef float f32x16 __attribute__((ext_vector_type(16)));
__device__ __forceinline__ unsigned cvtpk(float lo, float hi) { typedef float f2 __attribute__((ext_vector_type(2))); typedef __bf16 b2 __attribute__((ext_vector_type(2))); f2 v = {lo, hi}; b2 b = __builtin_convertvector(v, b2); return __builtin_bit_cast(unsigned, b); }
__device__ __forceinline__ float lo_half(float x) { const int l = (int)__builtin_amdgcn_mbcnt_hi(~0u, __builtin_amdgcn_mbcnt_lo(~0u, 0u)); return __shfl(x, l & 31); }
__device__ __forceinline__ float hi_half(float x) { const int l = (int)__builtin_amdgcn_mbcnt_hi(~0u, __builtin_amdgcn_mbcnt_lo(~0u, 0u)); return __shfl(x, (l & 31) + 32); }
__device__ __forceinline__ float other_half(float x) { const int l = (int)__builtin_amdgcn_mbcnt_hi(~0u, __builtin_amdgcn_mbcnt_lo(~0u, 0u)); return __shfl(x, l ^ 32); }
struct cpx { float re, im; };
__device__ __forceinline__ cpx cmul(cpx a, cpx b) { return {a.re * b.re - a.im * b.im, a.re * b.im + a.im * b.re}; }
__device__ __forceinline__ cpx cfma(cpx a, cpx b, cpx c) { float re = __builtin_fmaf(-a.im, b.im, __builtin_fmaf(a.re, b.re, c.re)), im = __builtin_fmaf(a.im, b.re, __builtin_fmaf(a.re, b.im, c.im));
#ifndef S5_ALLOW_PK
    asm("" : "+v"(re));
#endif
    return {re, im}; }

template <bool OUT>
__device__ __forceinline__ void run_blocks(LAS unsigned char* T, const bf16* pb, int dir, bf16* yout, int blk0, int nblk, cpx& S1, cpx& S2,
                                           const cpx (&ap1)[4], const cpx (&ap2)[4], const bf16x8 (&wf)[4], const LAS unsigned char* CF, int lane) {
    const int r = lane & 31, h = lane >> 5;
    v4u unext = *(const v4u*)(pb + (size_t)seqmap(32 * blk0 + r, dir) * PW + 8 * h);
    for (int blk = blk0; blk < blk0 + nblk; ++blk) {
        const bf16x8 uf = __builtin_bit_cast(bf16x8, unext);
        if (blk + 1 < blk0 + nblk) unext = *(const v4u*)(pb + (size_t)seqmap(32 * (blk + 1) + r, dir) * PW + 8 * h);
        const f32x16 z = {};
        f32x16 r1, i1, r2, i2; (void)z;
        asm volatile("v_mfma_f32_32x32x16_bf16 %0, %1, %2, 0" : "=&v"(r1) : "v"(uf), "v"(wf[0]));
        asm volatile("v_mfma_f32_32x32x16_bf16 %0, %1, %2, 0" : "=&v"(i1) : "v"(uf), "v"(wf[1]));
        asm volatile("v_mfma_f32_32x32x16_bf16 %0, %1, %2, 0" : "=&v"(r2) : "v"(uf), "v"(wf[2]));
        asm volatile("v_mfma_f32_32x32x16_bf16 %0, %1, %2, 0" : "=&v"(i2) : "v"(uf), "v"(wf[3]));
        asm volatile("s_nop 15\n\ts_nop 3" : "+v"(r1), "+v"(i1), "+v"(r2), "+v"(i2));
#pragma unroll
        for (int q = 0; q < 4; ++q)
#pragma unroll
            for (int i = 1; i < 4; ++i) { const int g = 4 * q + i;
                const cpx p1 = {r1[g - 1], i1[g - 1]}, p2 = {r2[g - 1], i2[g - 1]};
                const cpx n1 = cfma(ap1[0], p1, {r1[g], i1[g]}), n2 = cfma(ap2[0], p2, {r2[g], i2[g]});
                r1[g] = n1.re; i1[g] = n1.im; r2[g] = n2.re; i2[g] = n2.im; }
        cpx cin1[4], cin2[4];
        cpx e1[4], e2[4], o1[4], o2[4];
#pragma unroll
        for (int q = 0; q < 4; ++q) { e1[q] = {r1[4 * q + 3], i1[4 * q + 3]}; e2[q] = {r2[4 * q + 3], i2[4 * q + 3]}; }
#pragma unroll
        for (int q = 0; q < 4; ++q) { o1[q] = {other_half(e1[q].re), other_half(e1[q].im)}; o2[q] = {other_half(e2[q].re), other_half(e2[q].im)}; }
        cpx P1 = S1, P2 = S2;
#pragma unroll
        for (int q = 0; q < 4; ++q) {
            const cpx fe1 = h ? o1[q] : e1[q], fo1 = h ? e1[q] : o1[q], fe2 = h ? o2[q] : e2[q], fo2 = h ? e2[q] : o2[q];
            const cpx ce1 = P1, ce2 = P2;
            P1 = cfma(ap1[3], P1, fe1); P2 = cfma(ap2[3], P2, fe2);
            const cpx co1 = P1, co2 = P2;
            P1 = cfma(ap1[3], P1, fo1); P2 = cfma(ap2[3], P2, fo2);
            cin1[q] = h ? co1 : ce1; cin2[q] = h ? co2 : ce2;
        }
        S1 = P1; S2 = P2;
        if constexpr (OUT) {
#pragma unroll
            for (int q = 0; q < 4; ++q)
#pragma unroll
                for (int i = 0; i < 4; ++i) { const int g = 4 * q + i, t = 8 * q + 4 * h + i;
                    const cpx s1 = cfma(ap1[i], cin1[q], {r1[g], i1[g]}), s2 = cfma(ap2[i], cin2[q], {r2[g], i2[g]});
                    u32x2 w; w.x = cvtpk(s1.re, s1.im); w.y = cvtpk(s2.re, s2.im);
                    *(LAS u32x2*)(T + t * 256 + ((((r >> 1) ^ (t & 15))) << 4) + (r & 1) * 8) = w; }
            LDS_WAIT(); asm volatile("" ::: "memory"); SHIFT_AT(53);
            f32x16 y = {};
#pragma unroll
            for (int ks = 0; ks < 8; ++ks) { const bf16x8 af = *(const LAS bf16x8*)(T + r * 256 + (((2 * ks + h) ^ (r & 15)) << 4)); const bf16x8 cfv = *(const LAS bf16x8*)(CF + (ks * 64 + lane) * 16); y = __builtin_amdgcn_mfma_f32_32x32x16_bf16(af, cfv, y, 0, 0, 0); asm volatile("" :: "v"(af), "v"(cfv)); }
            LDS_WAIT(); asm volatile("" ::: "memory"); SHIFT_AT(54);
            if (r < 16) {
#pragma unroll
                for (int reg = 0; reg < 16; reg += 2) { const int t = (reg & 3) + 8 * (reg >> 2) + 4 * h; const unsigned w = cvtpk(y[reg], y[reg + 1]);
                    *(LAS unsigned short*)(T + t * 32 + r * 2) = (unsigned short)(w & 0xffffu); *(LAS unsigned short*)(T + (t + 1) * 32 + r * 2) = (unsigned short)(w >> 16); } }
            LDS_WAIT(); asm volatile("" ::: "memory");
            { const int t = lane >> 1, hf = lane & 1; const v4u ov = *(const LAS v4u*)(T + t * 32 + hf * 16);
              *(v4u*)(yout + (size_t)seqmap(32 * blk + t, dir) * 512 + hf * 8) = ov; }
            LDS_WAIT(); asm volatile("" ::: "memory");
        }
    }
}
__device__ __forceinline__ void chain4(LAS unsigned char* lds, const bf16* pb, const float2* a_tab, const float2* bb_tab, const v4u* cft, int dir, bf16* yout, int seg, int chain_slot) {
    int lane = threadIdx.x & 63; asm volatile("" : "+v"(lane)); const int r = lane & 31, h = lane >> 5;
    const int wv = chain_slot * 4 + seg;
    LAS unsigned char* T = lds + wv * 8192;
    LAS float* EX = (LAS float*)(lds + 65536) + chain_slot * 4 * 128;
    cpx ap1[4], ap2[4];
    { const float2 a1 = a_tab[r], a2 = a_tab[32 + r]; ap1[0] = {a1.x, a1.y}; ap2[0] = {a2.x, a2.y};
#pragma unroll
      for (int k = 1; k < 4; ++k) { ap1[k] = cmul(ap1[k - 1], ap1[0]); ap2[k] = cmul(ap2[k - 1], ap2[0]); } }
    bf16x8 wf[4];
#pragma unroll
    for (int gi = 0; gi < 4; ++gi) { const float2* bp = bb_tab + (size_t)((gi >> 1) * 32 + r) * 16 + 8 * h; float v[8];
#pragma unroll
        for (int j = 0; j < 8; ++j) v[j] = (gi & 1) ? bp[j].y : bp[j].x;
        v4u w; w.x = cvtpk(v[0], v[1]); w.y = cvtpk(v[2], v[3]); w.z = cvtpk(v[4], v[5]); w.w = cvtpk(v[6], v[7]); wf[gi] = __builtin_bit_cast(bf16x8, w); }
    constexpr int NBS = SB / 32 / 4;
    cpx S1 = {0.f, 0.f}, S2 = {0.f, 0.f};
    LAS unsigned char* CF = lds + 65536 + 4096 + chain_slot * 8192;
    SHIFT_AT(33);
    if (seg == 3) {
        v4u w[8];
#pragma unroll
        for (int ks = 0; ks < 8; ++ks) w[ks] = cft[ks * 32 + h * 16 + (r & 15)];
#pragma unroll
        for (int ks = 0; ks < 8; ++ks) { v4u o = w[ks]; if (r >= 16) o = v4u{0u, 0u, 0u, 0u}; *(LAS v4u*)(CF + (ks * 64 + lane) * 16) = o; }
    } else run_blocks<false>(T, pb, dir, yout, seg * NBS, NBS, S1, S2, ap1, ap2, wf, CF, lane);
    if (h == 0) { LAS float* e = EX + (seg * 32 + r) * 4; e[0] = S1.re; e[1] = S1.im; e[2] = S2.re; e[3] = S2.im; }
    __syncthreads(); SHIFT_AT(34);
    cpx p1 = ap1[3], p2 = ap2[3];
#pragma unroll
    for (int k = 0; k < 4; ++k) { p1 = cmul(p1, p1); p2 = cmul(p2, p2); }
    cpx q1 = p1, q2 = p2;
#pragma unroll
    for (int k = 0; k < 3; ++k) { q1 = cmul(q1, q1); q2 = cmul(q2, q2); }
    const cpx A1 = cmul(q1, p1), A2 = cmul(q2, p2);
    S1 = {0.f, 0.f}; S2 = {0.f, 0.f};
    for (int j = 0; j < seg; ++j) { const LAS float* e = EX + (j * 32 + r) * 4; S1 = cfma(A1, S1, {e[0], e[1]}); S2 = cfma(A2, S2, {e[2], e[3]}); }
    SHIFT_AT(35);
    run_blocks<true>(T, pb, dir, yout, seg * NBS, NBS, S1, S2, ap1, ap2, wf, CF, lane);
    SHIFT_AT(36);
    __syncthreads();
}
}

__global__ void __launch_bounds__(NWAVES * 64, 2) mk_fwd(Args args) {
    extern __shared__ __attribute__((aligned(16))) unsigned char lds[];
    struct { LAS unsigned char* lds; } F; F.lds = (LAS unsigned char*)lds;
    const int G = gridDim.x; int vcu; { const int bx = blockIdx.x; vcu = (G % 8 == 0) ? (bx % 8) * (G / 8) + bx / 8 : bx; }
    const int NGW = G * NWAVES; const size_t NTHR = (size_t)G * 512;
    volatile LAS unsigned* MISC = (volatile LAS unsigned*)(F.lds + MISC_OFF);
    for (int u = threadIdx.x; u < (LDS_BYTES - LDSCTL_OFF) / 4; u += NWAVES * 64) ((LAS unsigned*)(F.lds + LDSCTL_OFF))[u] = 0u;
#define PH_IDS int tid = threadIdx.x; asm volatile("" : "+v"(tid)); const int lane = tid & 63; const int wave = __builtin_amdgcn_readfirstlane(tid >> 6); \
    const int gw = vcu * NWAVES + wave; const size_t gtid = (size_t)vcu * 512 + tid; (void)lane; (void)gw; (void)gtid; PH_PTRS
    __syncthreads();
    XcdBarrier bar = xcd_barrier_post((unsigned*)(args.ws + WS_CTL) + CW_BAR, MISC + 8);
    (void)bar;
#define GRID_BAR() do { KArgsP B_ = (KArgsP)__builtin_amdgcn_kernarg_segment_ptr(); asm volatile("" : "+s"(B_)); XcdBarrier b_; b_.bar = (unsigned*)(B_->ws + WS_CTL) + CW_BAR; b_.x = xb_xcc_id(); \
    b_.st = (volatile LAS unsigned*)((LAS unsigned char*)lds + MISC_OFF) + 8; xcd_barrier(b_); if (DOUBLE_BAR) xcd_barrier(b_); } while (0)
#ifndef TIMING_UNIT
#define TIMING_UNIT 1e-4f
#endif
#ifdef TIMING_MASK
#define STAMP(pid) do { if (blockIdx.x == 0 && threadIdx.x == 0) { volatile LAS unsigned long long* tq = (volatile LAS unsigned long long*)((LAS unsigned char*)lds + LDSCTL_OFF + 64); \
        const unsigned long long now = __builtin_amdgcn_s_memrealtime(); tq[1 + (pid)] += now - tq[0]; tq[0] = now; } } while (0)
#else
#define STAMP(pid) do {} while (0)
#endif
    STAMP(15);

#define PH_PTRS KArgsP A_ = (KArgsP)__builtin_amdgcn_kernarg_segment_ptr(); asm volatile("" : "+s"(A_)); unsigned char* ws = A_->ws; \
    const float* x = A_->in[0]; const float* cvec = A_->in[1]; const float* ctx = A_->in[2]; const float* cctx = A_->in[3]; \
    const float* w_mod = A_->in[4]; const float* b_mod = A_->in[5]; const float* norm1_g = A_->in[6]; const float* norm2_g = A_->in[7]; const float* w_in = A_->in[8]; \
    const float* lam_re = A_->in[9]; const float* lam_im = A_->in[10]; const float* log_step = A_->in[11]; \
    const float* sb_re = A_->in[12]; const float* sb_im = A_->in[13]; const float* sc_re = A_->in[14]; const float* sc_im = A_->in[15]; \
    const float* ssm_d = A_->in[16]; const float* w_glu = A_->in[17]; const float* qng = A_->in[18]; const float* kng = A_->in[19]; \
    const float* gate_b = A_->in[20]; const float* ml_ng = A_->in[21]; \
    const float* w_br[3] = {A_->in[22], A_->in[23], A_->in[24]}; const float* w_out = A_->in[25]; \
    const float* w_q = A_->in[26]; const float* sk1 = A_->in[27]; const float* sk2 = A_->in[28]; \
    const float* pu = A_->in[29]; const float* pv = A_->in[30]; const float* fng = A_->in[31]; \
    float* out = A_->out; \
    float* mod = (float*)(ws + WS_MOD); float2* s5a = (float2*)(ws + WS_S5A); float2* s5bb = (float2*)(ws + WS_S5B); float2* ropet = (float2*)(ws + WS_ROPE); \
    bf16* Win_t = (bf16*)(ws + WS_WIN); bf16* Wglu_t = (bf16*)(ws + WS_WGLU); bf16* Wbr_t = (bf16*)(ws + WS_WBR); bf16* Wout_t = (bf16*)(ws + WS_WOUT); bf16* Wq_t = (bf16*)(ws + WS_WQ); \
    unsigned char* Utab0 = ws + WS_TAB;   \
    bf16* strm = (bf16*)(ws + WS_STRM); bf16* hA = (bf16*)(ws + WS_HA); bf16* ydir = (bf16*)(ws + WS_YDIR); bf16* proj = (bf16*)(ws + WS_PROJ); \
    float* scores = (float*)(ws + WS_SC); int* eidx = (int*)(ws + WS_EIDX); float* gates = (float*)(ws + WS_GATE); float* mln = (float*)(ws + WS_MLN); float* mlb = (float*)(ws + WS_MLB); v4u* s5cf = (v4u*)(ws + WS_S5CF); float2* sct = (float2*)(ws + WS_SCT);
    {
        {   PH_IDS
        if (vcu < 192) {
            const int l = vcu / 96, j0 = (vcu % 96) * 64;
            LAS float* sl = (LAS float*)F.lds;
            LAS float* red = sl + 9 * 1024;
            for (int i = tid; i < 9 * 1024; i += 512) { const int r = i >> 10, k = i & 1023; const float v = r < 8 ? cvec[r * 1024 + k] : cctx[k]; sl[i] = v / (1.f + expf(-v)); }
            __syncthreads();
            const int jl = tid & 63, kq = tid >> 6;
            float acc[9];
#pragma unroll
            for (int r = 0; r < 9; ++r) acc[r] = 0.f;
            const float* wp = w_mod + (size_t)l * 1024 * 6144 + j0 + jl;
#pragma unroll 16
            for (int k = kq * 128; k < kq * 128 + 128; ++k) { const float w = wp[(size_t)k * 6144];
#pragma unroll
                for (int r = 0; r < 9; ++r) acc[r] += sl[r * 1024 + k] * w; }
#pragma unroll
            for (int r = 0; r < 9; ++r) red[(kq * 9 + r) * 64 + jl] = acc[r];
            __syncthreads();
            for (int i = tid; i < 576; i += 512) { const int r = i >> 6, j = i & 63; float s = 0.f;
#pragma unroll
                for (int q = 0; q < 8; ++q) s += red[(q * 9 + r) * 64 + j];
                mod[(l * 9 + r) * 6144 + j0 + j] = s + b_mod[l * 6144 + j0 + j]; }
            __syncthreads();
        }
        for (int it = vcu; it < 256; it += G) {
            const int l = it >> 7, hh = (it >> 3) & 15, k0 = (it & 7) * 128;
            LAS float* wqT = (LAS float*)F.lds;
            LAS float* skT = wqT + 128 * 128;
            const float* wsrc = w_q + (size_t)l * 1024 * 2048 + hh * 128;
            const float* ssrc = ((hh & 1) ? sk2 : sk1) + l * 16384;
            {   const int rr = tid & 127, q = tid >> 7;
                const float* wr_ = wsrc + (size_t)(k0 + rr) * 2048 + q * 32; const float* sr_ = ssrc + rr * 128 + q * 32;
#pragma unroll
                for (int c = 0; c < 8; ++c) { const f32x4 a = *(const f32x4*)(wr_ + 4 * c), s4 = *(const f32x4*)(sr_ + 4 * c);
#pragma unroll
                    for (int e = 0; e < 4; ++e) { wqT[(q * 32 + 4 * c + e) * 128 + rr] = a[e]; skT[(q * 32 + 4 * c + e) * 128 + rr] = s4[e]; } } }
            __syncthreads();
            const int kt = tid & 15, keyt = tid >> 4;
            float acc[4][8];
#pragma unroll
            for (int a = 0; a < 4; ++a)
#pragma unroll
                for (int b2 = 0; b2 < 8; ++b2) acc[a][b2] = 0.f;
#pragma unroll 4
            for (int d = 0; d < 128; ++d) { const f32x4 w0 = *(const LAS f32x4*)(wqT + d * 128 + kt * 8), w1 = *(const LAS f32x4*)(wqT + d * 128 + kt * 8 + 4), s4 = *(const LAS f32x4*)(skT + d * 128 + keyt * 4);
#pragma unroll
                for (int a = 0; a < 4; ++a) { acc[a][0] += s4[a] * w0[0]; acc[a][1] += s4[a] * w0[1]; acc[a][2] += s4[a] * w0[2]; acc[a][3] += s4[a] * w0[3];
                    acc[a][4] += s4[a] * w1[0]; acc[a][5] += s4[a] * w1[1]; acc[a][6] += s4[a] * w1[2]; acc[a][7] += s4[a] * w1[3]; } }
#pragma unroll
            for (int a = 0; a < 4; ++a) { v4u o; o.x = pk2(acc[a][0], acc[a][1]); o.y = pk2(acc[a][2], acc[a][3]); o.z = pk2(acc[a][4], acc[a][5]); o.w = pk2(acc[a][6], acc[a][7]);
                *(v4u*)(Wq_t + ((size_t)l * 2048 + hh * 128 + keyt * 4 + a) * 1024 + k0 + kt * 8) = o; }
            __syncthreads();
        }
        {
            LAS float* scr = (LAS float*)(F.lds + wave * 16384);
            constexpr int I_IN = 16 * (PW / 32), I_GLU = 8 * 16, I_BR = 8 * 32, I_OUT = 16 * 32;
            constexpr int PER_L = I_IN + I_GLU + 3 * I_BR + I_OUT;
            for (int it = gw; it < 2 * PER_L; it += NGW) {
                const int l = it / PER_L; int r = it % PER_L;
                if (r < I_IN) { transpose_win(w_in + (size_t)l * DM_ * INW, Win_t + (size_t)l * PW * 1024, r, scr, lane); continue; } r -= I_IN;
                if (r < I_GLU) { transpose_plain(w_glu + (size_t)l * 512 * 512, 512, 512, Wglu_t + (size_t)l * 512 * 512, r, scr, lane); continue; } r -= I_GLU;
                if (r < 3 * I_BR) { const int br = r / I_BR; transpose_plain(w_br[br] + (size_t)l * 512 * 1024, 512, 1024, Wbr_t + ((size_t)l * 3 + br) * 1024 * 512, r % I_BR, scr, lane); continue; } r -= 3 * I_BR;
                transpose_plain(w_out + (size_t)l * 1024 * 1024, 1024, 1024, Wout_t + (size_t)l * 1024 * 1024, r, scr, lane);
            }
        }
        }
        {   PH_IDS
        if (G != 256) {
        convert_rows_peer(pu, pv, Utab0, sct, gtid, NTHR); }
        }
        {   PH_IDS
        for (size_t idx = gtid; idx < 2 * 4096; idx += NTHR) {
            const float step = expf(log_step[idx >> 6]);
            const float lr = lam_re[idx], li = lam_im[idx];
            const float mag = expf(lr * step); const float are = mag * cosf(li * step), aim = mag * sinf(li * step);
            const float den = lr * lr + li * li;
            const float zre = ((are - 1.f) * lr + aim * li) / den, zim = (aim * lr - (are - 1.f) * li) / den;
            s5a[idx] = make_float2(are, aim);
            for (int c = 0; c < 16; ++c) { const float br = sb_re[idx * 16 + c], bi = sb_im[idx * 16 + c]; s5bb[idx * 16 + c] = make_float2(zre * br - zim * bi, zre * bi + zim * br); }
        }
        for (size_t idx = gtid; idx < 128 * 256; idx += NTHR) {
            const int c = (int)idx & 15, h = ((int)idx >> 4) & 1, ks = ((int)idx >> 5) & 7, ci = (int)idx >> 8; float v[8];
#pragma unroll
            for (int j = 0; j < 8; ++j) { const int k = 16 * ks + 8 * h + j, n = 32 * ((k >> 1) & 1) + (k >> 2); v[j] = (k & 1) ? -sc_im[(size_t)ci * 1024 + c * 64 + n] : sc_re[(size_t)ci * 1024 + c * 64 + n]; }
            v4u w; w.x = pk2(v[0], v[1]); w.y = pk2(v[2], v[3]); w.z = pk2(v[4], v[5]); w.w = pk2(v[6], v[7]); s5cf[idx] = w;
        }
        for (size_t idx = gtid; idx < 64 * 16; idx += NTHR) { const int p = (int)idx >> 4, f = (int)idx & 15; const float inv = exp2f(-(float)f * (13.287712379549449f / 16.f)); const float ang = (float)p * inv; ropet[idx] = make_float2(cosf(ang), sinf(ang)); }
        }
    }
    GRID_BAR(); STAMP(0);
    { PH_IDS
    for (int row = gw; row < MROWS; row += NGW) {
        const int b = row / SB, t = row % SB;
        const float* src = t < NCTX ? ctx + ((size_t)b * NCTX + t) * DM_ : x + ((size_t)b * SEQ + (t - NCTX)) * DM_;
        norm_row<false>(src, strm + (size_t)row * DM_, norm1_g, mod + (t < NCTX ? 8 : b) * 6144, 0, 1, hA + (size_t)row * DM_, lane);
    } }
    GRID_BAR(); STAMP(1); SHIFT_HERE();

    for (int l = 0; l < 2; ++l) {
        {   PH_PTRS
            pg8::Gemm g{hA, Win_t + (size_t)l * PW * 1024, MROWS, PW, 1024, 1024, 1024}; G1Order S; S.init(l, G, (int)blockIdx.x);
            EpiProj E{proj};
            pg8::gemm_phase<EpiProj, G1Order, true, true>(F.lds, g, S, E);
            if (l == 0 && G == 256 && (int)blockIdx.x >= 80) {
                int tid2 = threadIdx.x; asm volatile("" : "+v"(tid2));
                const size_t gt2 = (size_t)((int)blockIdx.x - 80) * 512 + tid2, nt2 = (size_t)(G - 80) * 512;
                convert_rows_peer(pu, pv, Utab0, sct, gt2, nt2);
            }
        }
        GRID_BAR(); STAMP(2); SHIFT_AT(2);
        { PH_IDS
        const int i0 = 8 * (lane & 7), axis = i0 >> 5, half = (i0 >> 4) & 1, f0 = i0 & 15;
        f32x4 gq0 = *(const f32x4*)(qng + l * 64 + i0), gq1 = *(const f32x4*)(qng + l * 64 + i0 + 4), gk0 = *(const f32x4*)(kng + l * 64 + i0), gk1 = *(const f32x4*)(kng + l * 64 + i0 + 4);
#define P2_APPLY(ptr, rw, t_, G0, G1, SC) do { float x[8] = {bflo(rw.x), bfhi(rw.x), bflo(rw.y), bfhi(rw.y), bflo(rw.z), bfhi(rw.z), bflo(rw.w), bfhi(rw.w)}; \
            float ss = (x[0] * x[0] + x[1] * x[1]) + (x[2] * x[2] + x[3] * x[3]) + (x[4] * x[4] + x[5] * x[5]) + (x[6] * x[6] + x[7] * x[7]); \
            ss += __shfl_xor(ss, 1); ss += __shfl_xor(ss, 2); ss += __shfl_xor(ss, 4); \
            const float rr = rsqrtf(ss * (1.f / 64.f) + EPS_); float o[8]; \
            _Pragma("unroll") for (int j = 0; j < 8; ++j) x[j] *= rr * (j < 4 ? G0[j] : G1[j - 4]); \
            if ((t_) >= NCTX) { const int pos = (t_) - NCTX; const f32x4* cp = (const f32x4*)(ropet + (axis == 0 ? (pos >> 6) : (pos & 63)) * 16 + f0); \
                _Pragma("unroll") for (int q = 0; q < 4; ++q) { const f32x4 c2 = cp[q];            \
                    const float xa = x[2 * q], xb = x[2 * q + 1], pa = __shfl_xor(xa, 2), pb = __shfl_xor(xb, 2); \
                    o[2 * q] = half == 0 ? (xa * c2[0] - pa * c2[1]) : (pa * c2[1] + xa * c2[0]); o[2 * q + 1] = half == 0 ? (xb * c2[2] - pb * c2[3]) : (pb * c2[3] + xb * c2[2]); } \
            } else { _Pragma("unroll") for (int j = 0; j < 8; ++j) o[j] = x[j]; }                     \
            v4u w; w.x = pk2(o[0] * (SC), o[1] * (SC)); w.y = pk2(o[2] * (SC), o[3] * (SC)); w.z = pk2(o[4] * (SC), o[5] * (SC)); w.w = pk2(o[6] * (SC), o[7] * (SC)); *(v4u*)(ptr) = w; } while (0)
        for (int r4 = gw * 4; r4 < MROWS; r4 += NGW * 4) {
            const int t4 = r4 % SB; const bool doq = !(l == 1 && t4 < NCTX);
            bf16* qp = proj + (size_t)r4 * PW + PC_QA + lane * 8; bf16* kp = proj + (size_t)(r4 + (lane >> 4)) * PW + PC_KA + (lane & 15) * 8;
            v4u rq[4] = {}; const v4u rk = *(const v4u*)kp;
            if (doq) {
#pragma unroll
                for (int q = 0; q < 4; ++q) rq[q] = *(const v4u*)(qp + (size_t)q * PW); }
            P2_APPLY(kp, rk, t4 + (lane >> 4), gk0, gk1, 1.f);
            if (doq) {
#pragma unroll
                for (int q = 0; q < 4; ++q) P2_APPLY(qp + (size_t)q * PW, rq[q], t4 + q, gq0, gq1, ATT_C2); }
        }
#undef P2_APPLY
        }
        GRID_BAR(); STAMP(3); SHIFT_AT(3);
        { PH_IDS
#ifndef NO_ATT
        for (int u = vcu; u < (l == 0 ? 576 : 512); u += G) {
            const attn_body::bf16* P = (const attn_body::bf16*)proj;
            if (u < 512) { const int qb = u & 7, hq = (u >> 3) & 7, b = u >> 6; const size_t r0 = (size_t)b * SB;
                const attn_body::bf16* Qu = P + (r0 + NCTX + qb * 256) * PW + PC_QA + hq * 64;
                attn_body::attn_unit<8>(Qu, P + r0 * PW + PC_KA + (hq >> 2) * 64, P + r0 * PW + PC_VA + (hq >> 2) * 64, (attn_body::bf16*)Qu, 36, (char*)lds);
            } else { const int uu = u - 512, hq = uu & 7, b = uu >> 3; const size_t r0 = (size_t)b * SB;
                const attn_body::bf16* Qu = P + r0 * PW + PC_QA + hq * 64;
                attn_body::attn_unit<8>(Qu, P + r0 * PW + PC_KA + (hq >> 2) * 64, P + r0 * PW + PC_VA + (hq >> 2) * 64, (attn_body::bf16*)Qu, 4, (char*)lds);
            }
        }
#endif
        __syncthreads(); SHIFT_AT(31);
#ifndef NO_MLSTM
        for (int k5 = 0; ; ++k5) {
            int un = vcu + k5 * G;
            if (G == 256) { if (k5 == 4) { if (vcu < 64 || vcu >= 192) break; un = 1024 + (vcu - 64); } }
            if (un >= 1152) break;
            const int c = un % 18, dir = (un / 18) & 1, h = (un / 36) & 3, b = un / 144;
            ml::m1_unit(F.lds, proj + (size_t)b * SB * PW, gate_b + l * 16, h, dir, c, hA + (size_t)un * 16384, mln + (size_t)un * 128, mlb + un);
        }
#endif
        asm volatile(".p2align 8\n\t.rept " SHIFT_STR(S5_PIN_NOPS) "\n\ts_nop 0\n\t.endr");
        SHIFT_AT(32);
#ifndef NO_S5
        for (int c0 = vcu * 2; c0 < 512; c0 += 2 * G) {
            const int ch = c0 + (wave >> 2), b = ch >> 6, dir = (ch >> 5) & 1, g = ch & 31; const int ci = (l * 2 + dir) * 32 + g;
            s5::chain4(F.lds, proj + (size_t)b * SB * PW + PC_US + g * 16, s5a + (size_t)ci * 64, s5bb + (size_t)ci * 1024, s5cf + (size_t)ci * 256, dir,
                       ydir + ((size_t)dir * MROWS + (size_t)b * SB) * 512 + g * 16, wave & 3, wave >> 2);
        }
#endif
        }
        GRID_BAR(); STAMP(4); SHIFT_AT(4);
        { PH_IDS
#ifndef NO_MLSTM
        for (int un = vcu; un < (l == 0 ? 576 : 512); un += G) {
            int jc, h, b; if (l == 0) { jc = un % 18; h = (un / 18) & 3; b = un / 72; } else { jc = 2 + (un & 15); h = (un >> 4) & 3; b = un >> 6; }
            const size_t bh = (size_t)(b * 4 + h) * 2 * 18;
            ml::m3_unit(F.lds, proj + (size_t)b * SB * PW, gate_b + l * 16, ml_ng + l * 512 + h * 128, h, jc, hA + bh * 16384, mln + bh * 128, mlb + bh);
        }
#endif
        const bool spare64 = (l == 0 && G == 256);
        for (int row = spare64 ? (vcu - 64) * NWAVES + wave : gw; row < MROWS && row >= 0; row += spare64 ? (G - 64) * NWAVES : NGW) {
            bf16* pr = proj + (size_t)row * PW;
            const int c0 = lane * 8;
            {   const v4u uv = *(const v4u*)(pr + PC_US + c0), y0 = *(const v4u*)(ydir + (size_t)row * 512 + c0), y1 = *(const v4u*)(ydir + ((size_t)MROWS + row) * 512 + c0);
                const float* dk = ssm_d + l * 512 + c0; const f32x4 d0 = *(const f32x4*)dk, d1 = *(const f32x4*)(dk + 4);
                v4u w;
                w.x = pk2(gelu_tanh(d0[0] * bflo(uv.x) + bflo(y0.x) + bflo(y1.x)), gelu_tanh(d0[1] * bfhi(uv.x) + bfhi(y0.x) + bfhi(y1.x)));
                w.y = pk2(gelu_tanh(d0[2] * bflo(uv.y) + bflo(y0.y) + bflo(y1.y)), gelu_tanh(d0[3] * bfhi(uv.y) + bfhi(y0.y) + bfhi(y1.y)));
                w.z = pk2(gelu_tanh(d1[0] * bflo(uv.z) + bflo(y0.z) + bflo(y1.z)), gelu_tanh(d1[1] * bfhi(uv.z) + bfhi(y0.z) + bfhi(y1.z)));
                w.w = pk2(gelu_tanh(d1[2] * bflo(uv.w) + bflo(y0.w) + bflo(y1.w)), gelu_tanh(d1[3] * bfhi(uv.w) + bfhi(y0.w) + bfhi(y1.w)));
                *(v4u*)(pr + PC_US + c0) = w; }
        }
        if (l == 0 && G == 256 && vcu >= 64) {
            bf16* tmpA = (bf16*)(ws + WS_STRM + 36 * MiB);
            pg8::Gemm g{proj + PC_QA, Wbr_t + ((size_t)l * 3 + 1) * 1024 * 512, MROWS, 1024, 512, PW, 512}; EpiGate E{(const unsigned char*)(proj + PC_GL) + 1024, PW * 2, tmpA, 1024, 0, tmpA};
            { RowOrder S; S.init(0, 1024, G - 64, vcu - 64); pg8::gemm_phase<EpiGate, RowOrder, true, true>(F.lds, g, S, E); }
        }
        }
        GRID_BAR(); STAMP(5); SHIFT_AT(5);
        {   PH_PTRS
            pg8::Gemm g{proj + PC_US, Wglu_t + (size_t)l * 512 * 512, MROWS, 512, 512, PW, 512}; EpiGlu E{proj + PC_US, PW, ydir, 512};
            { RowOrder S; S.init(l, 512, G, (int)blockIdx.x); pg8::gemm_phase<EpiGlu, RowOrder, true, true>(F.lds, g, S, E); }
        }
        if (!(l == 0 && G == 256)) {   PH_PTRS
            pg8::Gemm g{proj + PC_QA, Wbr_t + ((size_t)l * 3 + 1) * 1024 * 512, MROWS, 1024, 512, PW, 512}; EpiGate E{(const unsigned char*)(proj + PC_GL) + 1024, PW * 2, hA, 1024, 0, hA};
            { RowOrder S; S.init(l, 1024, G, (int)blockIdx.x, l == 0 ? 144 : 0); pg8::gemm_phase<EpiGate, RowOrder, true, true>(F.lds, g, S, E); }
        }
        {   PH_PTRS
            const bool early_attn = (l == 0 && G == 256); const bf16* tmpA = (const bf16*)(ws + WS_STRM + 36 * MiB);
            pg8::Gemm g{proj + PC_QM, Wbr_t + ((size_t)l * 3 + 2) * 1024 * 512, MROWS, 1024, 512, PW, 512}; EpiGate E{(const unsigned char*)(proj + PC_GL) + 2048, PW * 2, hA, 1024, 1, early_attn ? tmpA : (const bf16*)hA};
            { RowOrder S; S.init(l, 1024, G, (int)blockIdx.x, l == 0 ? 144 : 0); pg8::gemm_phase<EpiGate, RowOrder, true, true>(F.lds, g, S, E); }
        }
        GRID_BAR(); STAMP(6); SHIFT_AT(6);
        {   PH_PTRS
            pg8::Gemm g{ydir, Wbr_t + ((size_t)l * 3 + 0) * 1024 * 512, MROWS, 1024, 512, 512, 512}; EpiGate E{(const unsigned char*)(proj + PC_GL), PW * 2, hA, 1024, 1, hA};
            { RowOrder S; S.init(l, 1024, G, (int)blockIdx.x); pg8::gemm_phase<EpiGate, RowOrder, true, true>(F.lds, g, S, E); }
        }
        GRID_BAR(); STAMP(7); SHIFT_AT(7);
        {   PH_PTRS
            pg8::Gemm g{hA, Wout_t + (size_t)l * 1024 * 1024, MROWS, 1024, 1024, 1024, 1024}; EpiResid E{strm, (mod + l * 9 * 6144), 2};
            { RowOrder S; S.init(l, 1024, G, (int)blockIdx.x); pg8::gemm_phase<EpiResid, RowOrder, true, true>(F.lds, g, S, E); }
            if (l == 0 && G > 32 && (int)blockIdx.x >= 32) {
                int tid2 = threadIdx.x; asm volatile("" : "+v"(tid2));
                const size_t gt2 = (size_t)((int)blockIdx.x - 32) * 512 + tid2, nt2 = (size_t)(G - 32) * 512;
                convert_rows_peer(pu + (size_t)16384 * 1024, pv + (size_t)16384 * 1024, Utab0 + (size_t)16384 * PEER_REC, sct + 16384, gt2, nt2);
            }
        }
        GRID_BAR(); STAMP(8); SHIFT_AT(8);
        { PH_IDS
        for (int row = gw; row < MROWS; row += NGW) {
            const int b = row / SB, t = row % SB;
            if (l == 1 && t < NCTX) continue;
            norm_row<true>(strm + (size_t)row * DM_, nullptr, norm2_g + l * 1024, (mod + l * 9 * 6144) + (t < NCTX ? 8 : b) * 6144, 3, 4, hA + (size_t)row * DM_, lane);
        } }
        GRID_BAR(); STAMP(9); SHIFT_AT(9);
        {   PH_PTRS
            pg8::Gemm g{hA, Wq_t + (size_t)l * 2048 * 1024, MROWS, 2048, 1024, 1024, 1024}; pg8::EpiBf16<0> E{(bf16*)scores, 2048, nullptr, 0, 0, 1.f};
            { RowOrder S; S.init(l, 2048, G, (int)blockIdx.x); pg8::gemm_phase<pg8::EpiBf16<0>, RowOrder, true, true>(F.lds, g, S, E); }
        }
        GRID_BAR(); STAMP(10); SHIFT_AT(10);
        {   PH_IDS
            LAS unsigned* wq = (LAS unsigned*)(F.lds + wave * 8192);
            const int ntask = (l == 0 ? MROWS : NB * SEQ) * 8;
            for (int q0 = gw * 64; q0 < ntask; q0 += NGW * 64) {
                const int q = q0 + lane; int pair;
                if (l == 0) pair = q; else { const int b = q >> 14, rem = q & 16383; pair = (b * SB + NCTX) * 8 + rem; }
                const bool live = q < ntask;
                const bf16* s = (const bf16*)scores + (size_t)(live ? pair : 0) * 256;
                float t1[16], t2[16];
#pragma unroll
                for (int hf = 0; hf < 2; ++hf) {
                    float tv[16];
                    const v4u* sp = (const v4u*)(s + hf * 128);
#define CEX(a, b) do { const float hi_ = fmaxf(a, b), lo_ = fminf(a, b); a = hi_; b = lo_; } while (0)
#pragma unroll 1
                    for (int gl = 0; gl < 2; ++gl) {
                    v4u ln[8];
#pragma unroll
                    for (int i = 0; i < 8; ++i) ln[i] = sp[gl * 8 + i];
#pragma unroll
                    for (int gq = 0; gq < 4; ++gq) { const int g4 = gl * 4 + gq;
                        float gv[16];
#pragma unroll
                        for (int n8 = 0; n8 < 2; ++n8) { const v4u x = ln[gq * 2 + n8]; const unsigned xw[4] = {x.x, x.y, x.z, x.w};
#pragma unroll
                            for (int e = 0; e < 4; ++e) { gv[n8 * 8 + 2 * e] = __uint_as_float((xw[e] << 16) | (unsigned)(g4 * 16 + n8 * 8 + 2 * e)); gv[n8 * 8 + 2 * e + 1] = __uint_as_float((xw[e] & 0xffff0000u) | (unsigned)(g4 * 16 + n8 * 8 + 2 * e + 1)); } }
                        CEX(gv[0], gv[13]); CEX(gv[1], gv[12]); CEX(gv[2], gv[15]); CEX(gv[3], gv[14]); CEX(gv[4], gv[8]); CEX(gv[5], gv[6]); CEX(gv[7], gv[11]); CEX(gv[9], gv[10]); CEX(gv[0], gv[5]); CEX(gv[1], gv[7]); CEX(gv[2], gv[9]); CEX(gv[3], gv[4]); CEX(gv[6], gv[13]); CEX(gv[8], gv[14]); CEX(gv[10], gv[15]); CEX(gv[11], gv[12]); CEX(gv[0], gv[1]); CEX(gv[2], gv[3]); CEX(gv[4], gv[5]); CEX(gv[6], gv[8]); CEX(gv[7], gv[9]); CEX(gv[10], gv[11]); CEX(gv[12], gv[13]); CEX(gv[14], gv[15]); CEX(gv[0], gv[2]); CEX(gv[1], gv[3]); CEX(gv[4], gv[10]); CEX(gv[5], gv[11]); CEX(gv[6], gv[7]); CEX(gv[8], gv[9]); CEX(gv[12], gv[14]); CEX(gv[13], gv[15]); CEX(gv[1], gv[2]); CEX(gv[3], gv[12]); CEX(gv[4], gv[6]); CEX(gv[5], gv[7]); CEX(gv[8], gv[10]); CEX(gv[9], gv[11]); CEX(gv[13], gv[14]); CEX(gv[1], gv[4]); CEX(gv[2], gv[6]); CEX(gv[5], gv[8]); CEX(gv[7], gv[10]); CEX(gv[9], gv[13]); CEX(gv[11], gv[14]); CEX(gv[2], gv[4]); CEX(gv[3], gv[6]); CEX(gv[9], gv[12]); CEX(gv[11], gv[13]); CEX(gv[3], gv[5]); CEX(gv[6], gv[8]); CEX(gv[7], gv[9]); CEX(gv[10], gv[12]); CEX(gv[3], gv[4]); CEX(gv[5], gv[6]); CEX(gv[7], gv[8]); CEX(gv[9], gv[10]); CEX(gv[11], gv[12]); CEX(gv[6], gv[7]); CEX(gv[8], gv[9]);
                        if (g4 == 0) {
#pragma unroll
                            for (int k2 = 0; k2 < 16; ++k2) tv[k2] = gv[k2];
                        } else {
#pragma unroll
                            for (int k2 = 0; k2 < 16; ++k2) tv[k2] = fmaxf(tv[k2], gv[15 - k2]);
                            CEX(tv[0], tv[8]); CEX(tv[1], tv[9]); CEX(tv[2], tv[10]); CEX(tv[3], tv[11]); CEX(tv[4], tv[12]); CEX(tv[5], tv[13]); CEX(tv[6], tv[14]); CEX(tv[7], tv[15]); CEX(tv[0], tv[4]); CEX(tv[1], tv[5]); CEX(tv[2], tv[6]); CEX(tv[3], tv[7]); CEX(tv[8], tv[12]); CEX(tv[9], tv[13]); CEX(tv[10], tv[14]); CEX(tv[11], tv[15]); CEX(tv[0], tv[2]); CEX(tv[1], tv[3]); CEX(tv[4], tv[6]); CEX(tv[5], tv[7]); CEX(tv[8], tv[10]); CEX(tv[9], tv[11]); CEX(tv[12], tv[14]); CEX(tv[13], tv[15]); CEX(tv[0], tv[1]); CEX(tv[2], tv[3]); CEX(tv[4], tv[5]); CEX(tv[6], tv[7]); CEX(tv[8], tv[9]); CEX(tv[10], tv[11]); CEX(tv[12], tv[13]); CEX(tv[14], tv[15]);
                        }
                    }
                    }
#undef CEX
#pragma unroll
                    for (int k2 = 0; k2 < 16; ++k2) { if (hf == 0) t1[k2] = tv[k2]; else t2[k2] = tv[k2]; wq[(hf * 16 + k2) * 64 + lane] = __float_as_uint(tv[k2]); }
                }
#define CAND(i2, j2) __uint_as_float((__float_as_uint(t1[i2] + t2[j2]) & ~255u) | (unsigned)(255 - ((i2) * 16 + (j2))))
#define CEX(a, b) do { const float hi_ = fmaxf(a, b), lo_ = fminf(a, b); a = hi_; b = lo_; } while (0)
#define BSORT16() do { CEX(ts[0], ts[8]); CEX(ts[1], ts[9]); CEX(ts[2], ts[10]); CEX(ts[3], ts[11]); CEX(ts[4], ts[12]); CEX(ts[5], ts[13]); CEX(ts[6], ts[14]); CEX(ts[7], ts[15]); CEX(ts[0], ts[4]); CEX(ts[1], ts[5]); CEX(ts[2], ts[6]); CEX(ts[3], ts[7]); CEX(ts[8], ts[12]); CEX(ts[9], ts[13]); CEX(ts[10], ts[14]); CEX(ts[11], ts[15]); CEX(ts[0], ts[2]); CEX(ts[1], ts[3]); CEX(ts[4], ts[6]); CEX(ts[5], ts[7]); CEX(ts[8], ts[10]); CEX(ts[9], ts[11]); CEX(ts[12], ts[14]); CEX(ts[13], ts[15]); CEX(ts[0], ts[1]); CEX(ts[2], ts[3]); CEX(ts[4], ts[5]); CEX(ts[6], ts[7]); CEX(ts[8], ts[9]); CEX(ts[10], ts[11]); CEX(ts[12], ts[13]); CEX(ts[14], ts[15]); } while (0)
                float ts[16];
#pragma unroll
                for (int k2 = 0; k2 < 16; ++k2) ts[k2] = CAND(0, k2);
#pragma unroll
                for (int k2 = 1; k2 < 16; ++k2) ts[k2] = fmaxf(ts[k2], CAND(16 - k2, 0));
                BSORT16();
#pragma unroll
                for (int k2 = 9; k2 < 16; ++k2) ts[k2] = fmaxf(ts[k2], CAND(1, 16 - k2));
                BSORT16();
#pragma unroll
                for (int k2 = 10; k2 < 16; ++k2) ts[k2] = fmaxf(ts[k2], CAND(17 - k2, 1));
                BSORT16();
#pragma unroll
                for (int k2 = 13; k2 < 16; ++k2) ts[k2] = fmaxf(ts[k2], CAND(2, 17 - k2));
                BSORT16();
                {   float c3[3] = {CAND(3, 2), CAND(3, 3), CAND(4, 2)};
#pragma unroll
                    for (int q3 = 0; q3 < 3; ++q3) { float c = c3[q3];
#pragma unroll
                        for (int k2 = 0; k2 < 16; ++k2) { const float hi = fmaxf(ts[k2], c); c = fminf(ts[k2], c); ts[k2] = hi; } } }
#undef BSORT16
#undef CEX
#undef CAND
                LDS_WAIT(); asm volatile("" ::: "memory");
                int eo[16]; float go[16];
#pragma unroll
                for (int k2 = 0; k2 < 16; ++k2) { const unsigned id = 255u - (__float_as_uint(ts[k2]) & 255u);
                    const unsigned k1 = wq[(id >> 4) * 64 + lane] & 127u, kk2 = wq[(16 + (id & 15u)) * 64 + lane] & 127u;
                    eo[k2] = (int)(k1 * 128u + kk2); go[k2] = __expf(ts[k2] - ts[0]); }
                if (live) { int* ep = eidx + (size_t)pair * 16; float* gp = gates + (size_t)pair * 16;
#pragma unroll
                    for (int k4 = 0; k4 < 4; ++k4) { *(v4u*)(ep + 4 * k4) = (v4u){(unsigned)eo[4 * k4], (unsigned)eo[4 * k4 + 1], (unsigned)eo[4 * k4 + 2], (unsigned)eo[4 * k4 + 3]};
                        *(f32x4*)(gp + 4 * k4) = (f32x4){go[4 * k4], go[4 * k4 + 1], go[4 * k4 + 2], go[4 * k4 + 3]}; } }
                LDS_WAIT(); asm volatile("" ::: "memory");
            }
        }
        GRID_BAR(); STAMP(11); SHIFT_AT(11);
#ifndef NO_P11
        { PH_IDS
#if defined(PEER_FP4) && !defined(PEER_NOSPLIT)
        LAS float* cl = (LAS float*)(F.lds + wave * 4608);
        const unsigned char* Utab = Utab0 + (size_t)l * 16384 * F4_REC; const float2* sc = sct + (size_t)l * 16384;
        const int L = lane & 31; const bool hh = lane >= 32; const unsigned L16 = (unsigned)L * 16u;
#define F4_PAIR(w, b) __builtin_amdgcn_cvt_scalef32_pk_f32_fp4((w), 1.f, (b))
#define PG_LOAD(R_, off, i0) do { _Pragma("unroll") for (int k = 0; k < 8; ++k) { \
            const int ea = __builtin_amdgcn_readlane((i0) < 64 ? e0 : e1, ((i0) + 2 * k) & 63), eb = __builtin_amdgcn_readlane((i0) < 64 ? e0 : e1, ((i0) + 2 * k + 1) & 63); \
            R_[k] = *(const v4u*)(Utab + (off) + ((unsigned)(hh ? eb : ea) * (unsigned)F4_REC + L16)); } } while (0)
        for (int ki = 0, row = gw; row < MROWS; row += NGW, ++ki) {
            const int t = row % SB;
            if (l == 1 && t < NCTX) continue;
            f32x2 xf2[16];
            {   const v4u* xp = (const v4u*)(hA + (size_t)row * 1024 + L * 32); const v4u x0 = xp[0], x1 = xp[1], x2 = xp[2], x3 = xp[3];
                const unsigned xw[16] = {x0.x, x0.y, x0.z, x0.w, x1.x, x1.y, x1.z, x1.w, x2.x, x2.y, x2.z, x2.w, x3.x, x3.y, x3.z, x3.w};
#pragma unroll
                for (int i = 0; i < 16; ++i) xf2[i] = f32x2{bflo(xw[i]), bfhi(xw[i])}; }
            const int e0 = eidx[(size_t)row * 128 + lane], e1 = eidx[(size_t)row * 128 + 64 + lane];
            float g0 = gates[(size_t)row * 128 + lane], g1 = gates[(size_t)row * 128 + 64 + lane];
            const float2 sc0 = sc[e0], sc1 = sc[e1];
            {   float s0 = g0, s1 = g1;
                s0 += __shfl_xor(s0, 1); s1 += __shfl_xor(s1, 1); s0 += __shfl_xor(s0, 2); s1 += __shfl_xor(s1, 2); s0 += __shfl_xor(s0, 4); s1 += __shfl_xor(s1, 4); s0 += __shfl_xor(s0, 8); s1 += __shfl_xor(s1, 8);
                g0 = g0 / s0 * sc0.y; g1 = g1 / s1 * sc1.y; }
            v4u Au[8], Bu[8];
#define PG_DOT(U_, i0) do { float d[8]; _Pragma("unroll") for (int k = 0; k < 8; ++k) { const unsigned uw[4] = {U_[k].x, U_[k].y, U_[k].z, U_[k].w}; \
                    f32x2 pa = F4_PAIR(uw[0], 0) * xf2[0], pb = F4_PAIR(uw[0], 1) * xf2[1]; pa += F4_PAIR(uw[0], 2) * xf2[2]; pb += F4_PAIR(uw[0], 3) * xf2[3]; \
                    _Pragma("unroll") for (int q = 1; q < 4; ++q) { pa += F4_PAIR(uw[q], 0) * xf2[4 * q]; pb += F4_PAIR(uw[q], 1) * xf2[4 * q + 1]; pa += F4_PAIR(uw[q], 2) * xf2[4 * q + 2]; pb += F4_PAIR(uw[q], 3) * xf2[4 * q + 3]; } \
                    pa += pb; d[k] = pa.x + pa.y; } \
                const bool o1 = lane & 1, o2 = lane & 2, o4 = lane & 4; float b4[4], c2_[2]; \
                _Pragma("unroll") for (int q = 0; q < 4; ++q) b4[q] = (o1 ? d[2 * q + 1] : d[2 * q]) + __shfl_xor(o1 ? d[2 * q] : d[2 * q + 1], 1);         \
                _Pragma("unroll") for (int q = 0; q < 2; ++q) c2_[q] = (o2 ? b4[2 * q + 1] : b4[2 * q]) + __shfl_xor(o2 ? b4[2 * q] : b4[2 * q + 1], 2);     \
                float tt = (o4 ? c2_[1] : c2_[0]) + __shfl_xor(o4 ? c2_[0] : c2_[1], 4);                                                               \
                tt += __shfl_xor(tt, 8); tt += __shfl_xor(tt, 16);        \
                const int sl = (lane - (i0)) & 15; const float town = __shfl(tt, (sl & 1) * 32 + (sl >> 1));     \
                const float cown = ((i0) < 64 ? g0 : g1) * gelu_tanh(town * ((i0) < 64 ? sc0.x : sc1.x)); \
                if (((lane - (i0)) & 63) < 16) cl[ki * 128 + (i0) + ((lane - (i0)) & 63)] = cown; } while (0)
            PG_LOAD(Au, 0, 0);
            for (int i0 = 0; i0 < 128; i0 += 32) {
                PG_LOAD(Bu, 0, i0 + 16);
                PG_DOT(Au, i0);
                if (i0 + 32 < 128) PG_LOAD(Au, 0, i0 + 32);
                PG_DOT(Bu, i0 + 16);
            }
#undef PG_DOT
        }
#ifdef PEER_SPLIT_BAR
        GRID_BAR();
#endif
        for (int ki = 0, row = gw; row < MROWS; row += NGW, ++ki) {
            const int b = row / SB, t = row % SB;
            if (l == 1 && t < NCTX) continue;
            const int e0 = eidx[(size_t)row * 128 + lane], e1 = eidx[(size_t)row * 128 + 64 + lane];
            f32x2 acc2[16];
#pragma unroll
            for (int i = 0; i < 16; ++i) acc2[i] = f32x2{0.f, 0.f};
            v4u Av[8], Bv[8];
#define PG_AXPY(V_, i0) do { _Pragma("unroll") for (int k = 0; k < 8; ++k) { const f32x2 cab = *(const LAS f32x2*)(cl + ki * 128 + (i0) + 2 * k); \
                    const float c = hh ? cab.y : cab.x; const f32x2 c2 = f32x2{c, c}; const unsigned vw[4] = {V_[k].x, V_[k].y, V_[k].z, V_[k].w}; \
                    _Pragma("unroll") for (int q = 0; q < 4; ++q) { acc2[4 * q] += c2 * F4_PAIR(vw[q], 0); acc2[4 * q + 1] += c2 * F4_PAIR(vw[q], 1); acc2[4 * q + 2] += c2 * F4_PAIR(vw[q], 2); acc2[4 * q + 3] += c2 * F4_PAIR(vw[q], 3); } } } while (0)
            PG_LOAD(Av, 512, 0);
            for (int i0 = 0; i0 < 128; i0 += 32) {
                PG_LOAD(Bv, 512, i0 + 16);
                PG_AXPY(Av, i0);
                if (i0 + 32 < 128) PG_LOAD(Av, 512, i0 + 32);
                PG_AXPY(Bv, i0 + 16);
            }
#undef PG_AXPY
            float accf[16];
#pragma unroll
            for (int i = 0; i < 16; ++i) { const float ajl = (i & 1) ? acc2[i >> 1].y : acc2[i >> 1].x, ajh = (i & 1) ? acc2[8 + (i >> 1)].y : acc2[8 + (i >> 1)].x;
                const float keep = hh ? ajh : ajl, give = hh ? ajl : ajh; accf[i] = keep + __shfl_xor(give, 32); }
#else
        for (int row = gw; row < MROWS; row += NGW) {
            const int b = row / SB, t = row % SB;
            if (l == 1 && t < NCTX) continue;
#endif
#if defined(PEER_FP4) && !defined(PEER_NOSPLIT)
#elif defined(PEER_FP4)
            const unsigned char* Utab = Utab0 + (size_t)l * 16384 * F4_REC; const float2* sc = sct + (size_t)l * 16384;
            const int L = lane & 31; const bool hh = lane >= 32; const unsigned L16 = (unsigned)L * 16u;
            f32x2 xf2[16];
            {   const v4u* xp = (const v4u*)(hA + (size_t)row * 1024 + L * 32); const v4u x0 = xp[0], x1 = xp[1], x2 = xp[2], x3 = xp[3];
                const unsigned xw[16] = {x0.x, x0.y, x0.z, x0.w, x1.x, x1.y, x1.z, x1.w, x2.x, x2.y, x2.z, x2.w, x3.x, x3.y, x3.z, x3.w};
#pragma unroll
                for (int i = 0; i < 16; ++i) xf2[i] = f32x2{bflo(xw[i]), bfhi(xw[i])}; }
            const int e0 = eidx[(size_t)row * 128 + lane], e1 = eidx[(size_t)row * 128 + 64 + lane];
            float g0 = gates[(size_t)row * 128 + lane], g1 = gates[(size_t)row * 128 + 64 + lane];
            const float2 sc0 = sc[e0], sc1 = sc[e1];
            {   float s0 = g0, s1 = g1;
                s0 += __shfl_xor(s0, 1); s1 += __shfl_xor(s1, 1); s0 += __shfl_xor(s0, 2); s1 += __shfl_xor(s1, 2); s0 += __shfl_xor(s0, 4); s1 += __shfl_xor(s1, 4); s0 += __shfl_xor(s0, 8); s1 += __shfl_xor(s1, 8);
                g0 = g0 / s0 * sc0.y; g1 = g1 / s1 * sc1.y; }
            f32x2 acc2[16];
#pragma unroll
            for (int i = 0; i < 16; ++i) acc2[i] = f32x2{0.f, 0.f};
            v4u Au[4], Av[4], Bu[4], Bv[4];
#define PG_LOAD(U_, V_, i0) do { _Pragma("unroll") for (int k = 0; k < 4; ++k) { \
                const int ea = __builtin_amdgcn_readlane((i0) < 64 ? e0 : e1, ((i0) + 2 * k) & 63), eb = __builtin_amdgcn_readlane((i0) < 64 ? e0 : e1, ((i0) + 2 * k + 1) & 63); \
                const unsigned ro = (unsigned)(hh ? eb : ea) * (unsigned)F4_REC + L16; \
                U_[k] = *(const v4u*)(Utab + ro); V_[k] = *(const v4u*)(Utab + 512 + ro); } } while (0)
#define F4_PAIR(w, b) __builtin_amdgcn_cvt_scalef32_pk_f32_fp4((w), 1.f, (b))
#define PG_COMP(U_, V_, i0) do { float d[4]; _Pragma("unroll") for (int k = 0; k < 4; ++k) { const unsigned uw[4] = {U_[k].x, U_[k].y, U_[k].z, U_[k].w}; \
                    f32x2 pa = F4_PAIR(uw[0], 0) * xf2[0], pb = F4_PAIR(uw[0], 1) * xf2[1]; pa += F4_PAIR(uw[0], 2) * xf2[2]; pb += F4_PAIR(uw[0], 3) * xf2[3]; \
                    _Pragma("unroll") for (int q = 1; q < 4; ++q) { pa += F4_PAIR(uw[q], 0) * xf2[4 * q]; pb += F4_PAIR(uw[q], 1) * xf2[4 * q + 1]; pa += F4_PAIR(uw[q], 2) * xf2[4 * q + 2]; pb += F4_PAIR(uw[q], 3) * xf2[4 * q + 3]; } \
                    pa += pb; d[k] = pa.x + pa.y; } \
                const bool o1 = lane & 1, o2 = lane & 2; \
                float a01 = (o1 ? d[1] : d[0]) + __shfl_xor(o1 ? d[0] : d[1], 1), a23 = (o1 ? d[3] : d[2]) + __shfl_xor(o1 ? d[2] : d[3], 1); \
                float tt = (o2 ? a23 : a01) + __shfl_xor(o2 ? a01 : a23, 2); \
                tt += __shfl_xor(tt, 4); tt += __shfl_xor(tt, 8); tt += __shfl_xor(tt, 16);             \
                const int sl = (lane - (i0)) & 7; const float town = __shfl(tt, (sl & 1) * 32 + (sl >> 1));     \
                const float cown = ((i0) < 64 ? g0 : g1) * gelu_tanh(town * ((i0) < 64 ? sc0.x : sc1.x));         \
                _Pragma("unroll") for (int k = 0; k < 4; ++k) { \
                    const float ca = __uint_as_float(__builtin_amdgcn_readlane(__float_as_uint(cown), ((i0) + 2 * k) & 63)), cb = __uint_as_float(__builtin_amdgcn_readlane(__float_as_uint(cown), ((i0) + 2 * k + 1) & 63)); \
                    const float c = hh ? cb : ca; const f32x2 c2 = f32x2{c, c}; const unsigned vw[4] = {V_[k].x, V_[k].y, V_[k].z, V_[k].w}; \
                    _Pragma("unroll") for (int q = 0; q < 4; ++q) { acc2[4 * q] += c2 * F4_PAIR(vw[q], 0); acc2[4 * q + 1] += c2 * F4_PAIR(vw[q], 1); acc2[4 * q + 2] += c2 * F4_PAIR(vw[q], 2); acc2[4 * q + 3] += c2 * F4_PAIR(vw[q], 3); } } } while (0)
            PG_LOAD(Au, Av, 0);
            for (int i0 = 0; i0 < 128; i0 += 16) {
                PG_LOAD(Bu, Bv, i0 + 8);
                PG_COMP(Au, Av, i0);
                if (i0 + 16 < 128) PG_LOAD(Au, Av, i0 + 16);
                PG_COMP(Bu, Bv, i0 + 8);
            }
#undef PG_LOAD
#undef PG_COMP
#undef F4_PAIR
            float accf[16];
#pragma unroll
            for (int i = 0; i < 16; ++i) { const float ajl = (i & 1) ? acc2[i >> 1].y : acc2[i >> 1].x, ajh = (i & 1) ? acc2[8 + (i >> 1)].y : acc2[8 + (i >> 1)].x;
                const float keep = hh ? ajh : ajl, give = hh ? ajl : ajh; accf[i] = keep + __shfl_xor(give, 32); }
#else
            const unsigned char* Utab = Utab0 + (size_t)l * 16384 * F6_REC; const float2* sc = sct + (size_t)l * 16384;
            const int L = lane & 31; const bool hh = lane >= 32; const unsigned L16 = (unsigned)L * 16u, L8 = 512u + (unsigned)L * 8u;
            typedef __bf16 bf2_t __attribute__((ext_vector_type(2))); typedef __bf16 bf32_t __attribute__((ext_vector_type(32))); typedef unsigned v16u_t __attribute__((ext_vector_type(16)));
            f32x2 xf2[16];
            {   const v4u* xp = (const v4u*)(hA + (size_t)row * 1024 + L * 32); const v4u x0 = xp[0], x1 = xp[1], x2 = xp[2], x3 = xp[3];
                const unsigned xw[16] = {x0.x, x0.y, x0.z, x0.w, x1.x, x1.y, x1.z, x1.w, x2.x, x2.y, x2.z, x2.w, x3.x, x3.y, x3.z, x3.w};
#pragma unroll
                for (int i = 0; i < 16; ++i) { const int da = f6_dim(2 * i), db = f6_dim(2 * i + 1);
                    xf2[i] = f32x2{(da & 1) ? bfhi(xw[da >> 1]) : bflo(xw[da >> 1]), (db & 1) ? bfhi(xw[db >> 1]) : bflo(xw[db >> 1])}; } }
            const int e0 = eidx[(size_t)row * 128 + lane], e1 = eidx[(size_t)row * 128 + 64 + lane];
            float g0 = gates[(size_t)row * 128 + lane], g1 = gates[(size_t)row * 128 + 64 + lane];
            const float2 sc0 = sc[e0], sc1 = sc[e1];
            {   float s0 = g0, s1 = g1;
                s0 += __shfl_xor(s0, 1); s1 += __shfl_xor(s1, 1); s0 += __shfl_xor(s0, 2); s1 += __shfl_xor(s1, 2); s0 += __shfl_xor(s0, 4); s1 += __shfl_xor(s1, 4); s0 += __shfl_xor(s0, 8); s1 += __shfl_xor(s1, 8);
                g0 = g0 / s0 * sc0.y; g1 = g1 / s1 * sc1.y; }
            f32x2 acc2[16];
#pragma unroll
            for (int i = 0; i < 16; ++i) acc2[i] = f32x2{0.f, 0.f};
            v4u Au4[2], Av4[2], Bu4[2], Bv4[2]; u32x2 Au2[2], Av2[2], Bu2[2], Bv2[2];
#define PG_LOAD(U4_, U2_, V4_, V2_, i0) do { _Pragma("unroll") for (int k = 0; k < 2; ++k) { \
                const int ea = __builtin_amdgcn_readlane((i0) < 64 ? e0 : e1, ((i0) + 2 * k) & 63), eb = __builtin_amdgcn_readlane((i0) < 64 ? e0 : e1, ((i0) + 2 * k + 1) & 63); \
                const unsigned ro = (unsigned)(hh ? eb : ea) * (unsigned)F6_REC, o16 = ro + L16, o8 = ro + L8;        \
                U4_[k] = *(const v4u*)(Utab + o16); U2_[k] = *(const u32x2*)(Utab + o8); V4_[k] = *(const v4u*)(Utab + 768 + o16); V2_[k] = *(const u32x2*)(Utab + 768 + o8); } } while (0)
#define PG_COMP(U4_, U2_, V4_, V2_, i0) do { float d[2]; _Pragma("unroll") for (int k = 0; k < 2; ++k) { \
                    const v32f r = __builtin_amdgcn_cvt_scalef32_pk32_f32_fp6(v6u{U4_[k].x, U4_[k].y, U4_[k].z, U4_[k].w, U2_[k].x, U2_[k].y}, 1.f); \
                    f32x2 pa = f32x2{r[0], r[1]} * xf2[0], pb = f32x2{r[2], r[3]} * xf2[1]; \
                    _Pragma("unroll") for (int i = 2; i < 16; i += 2) { pa += f32x2{r[2 * i], r[2 * i + 1]} * xf2[i]; pb += f32x2{r[2 * i + 2], r[2 * i + 3]} * xf2[i + 1]; } \
                    pa += pb; d[k] = pa.x + pa.y; } \
                const bool o1 = lane & 1; \
                float tt = (o1 ? d[1] : d[0]) + __shfl_xor(o1 ? d[0] : d[1], 1); \
                tt += __shfl_xor(tt, 2); tt += __shfl_xor(tt, 4); tt += __shfl_xor(tt, 8); tt += __shfl_xor(tt, 16);             \
                const int sl = (lane - (i0)) & 3; const float town = __shfl(tt, (sl & 1) * 32 + (sl >> 1));     \
                const float cown = ((i0) < 64 ? g0 : g1) * gelu_tanh(town * ((i0) < 64 ? sc0.x : sc1.x));         \
                _Pragma("unroll") for (int k = 0; k < 2; ++k) { \
                    const float ca = __uint_as_float(__builtin_amdgcn_readlane(__float_as_uint(cown), ((i0) + 2 * k) & 63)), cb = __uint_as_float(__builtin_amdgcn_readlane(__float_as_uint(cown), ((i0) + 2 * k + 1) & 63)); \
                    const float c = hh ? cb : ca; \
                    const v32f r = __builtin_amdgcn_cvt_scalef32_pk32_f32_fp6(v6u{V4_[k].x, V4_[k].y, V4_[k].z, V4_[k].w, V2_[k].x, V2_[k].y}, 1.f); \
                    const f32x2 c2 = f32x2{c, c}; \
                    _Pragma("unroll") for (int i = 0; i < 16; ++i) acc2[i] += c2 * f32x2{r[2 * i], r[2 * i + 1]}; } } while (0)
            PG_LOAD(Au4, Au2, Av4, Av2, 0);
            for (int i0 = 0; i0 < 128; i0 += 8) {
                PG_LOAD(Bu4, Bu2, Bv4, Bv2, i0 + 4);
                PG_COMP(Au4, Au2, Av4, Av2, i0);
                if (i0 + 8 < 128) PG_LOAD(Au4, Au2, Av4, Av2, i0 + 8);
                PG_COMP(Bu4, Bu2, Bv4, Bv2, i0 + 4);
            }
#undef PG_LOAD
#undef PG_COMP
            float accf[16];
#pragma unroll
            for (int i = 0; i < 16; ++i) { const int jl = F6_INTERLEAVED ? 2 * i : i, jh = F6_INTERLEAVED ? 2 * i + 1 : 16 + i;
                const float ajl = (jl & 1) ? acc2[jl >> 1].y : acc2[jl >> 1].x, ajh = (jh & 1) ? acc2[jh >> 1].y : acc2[jh >> 1].x;
                const float keep = hh ? ajh : ajl, give = hh ? ajl : ajh; accf[i] = keep + __shfl_xor(give, 32); }
#endif
            int lane2 = threadIdx.x & 63; asm volatile("" : "+v"(lane2)); lane2 = 2 * (lane2 & 31) + (lane2 >> 5);
            const float* g2 = (mod + l * 9 * 6144) + (t < NCTX ? 8 : b) * 6144 + 5 * 1024;
            bf16* sp = strm + (size_t)row * DM_;
            float sv_[16]; float ss = 0.f;
#pragma unroll
            for (int q = 0; q < 4; ++q) { const int c = lane2 * 16 + q * 4; const u32x2 sw = *(const u32x2*)(sp + c); const f32x4 s = f32x4{bflo(sw.x), bfhi(sw.x), bflo(sw.y), bfhi(sw.y)}, gg = *(const f32x4*)(g2 + c);
#pragma unroll
                for (int j = 0; j < 4; ++j) { const float v = s[j] + gg[j] * accf[q * 4 + j]; sv_[q * 4 + j] = v; ss += v * v; } }
            const float r = rsqrtf(wave_sum(ss) * (1.f / DM_) + EPS_);
            if (l == 0) {
#pragma unroll
                for (int q = 0; q < 4; ++q) { const int c = lane2 * 16 + q * 4; u32x2 w; w.x = pk2(sv_[q * 4], sv_[q * 4 + 1]); w.y = pk2(sv_[q * 4 + 2], sv_[q * 4 + 3]); *(u32x2*)(sp + c) = w; }
                const float* m1 = mod + (9 + (t < NCTX ? 8 : b)) * 6144; const float* gam = norm1_g + 1024;
#pragma unroll
                for (int hf = 0; hf < 2; ++hf) { const int c = lane2 * 16 + hf * 8; float o[8];
#pragma unroll
                    for (int j = 0; j < 8; ++j) o[j] = sv_[hf * 8 + j] * r * gam[c + j] * (1.f + m1[1024 + c + j]) + m1[c + j];
                    v4u w; w.x = pk2(o[0], o[1]); w.y = pk2(o[2], o[3]); w.z = pk2(o[4], o[5]); w.w = pk2(o[6], o[7]);
                    *(v4u*)(hA + (size_t)row * 1024 + c) = w; }
            } else {
                float* op = out + ((size_t)b * SEQ + (t - NCTX)) * DM_;
#pragma unroll
                for (int q = 0; q < 4; ++q) { const int c = lane2 * 16 + q * 4; const f32x4 gg = *(const f32x4*)(fng + c);
                    *(f32x4*)(op + c) = (f32x4){sv_[q * 4] * r * gg[0], sv_[q * 4 + 1] * r * gg[1], sv_[q * 4 + 2] * r * gg[2], sv_[q * 4 + 3] * r * gg[3]}; }
            }
        }
#if defined(PEER_FP4) && !defined(PEER_NOSPLIT)
#undef PG_LOAD
#undef F4_PAIR
#endif
        }
#endif
        if (l == 0) { GRID_BAR(); STAMP(12); }
    }
#ifdef F6_DIAG
    GRID_BAR();
    if (blockIdx.x == 0 && threadIdx.x == 0) { KArgsP A_ = (KArgsP)__builtin_amdgcn_kernarg_segment_ptr(); const float* dg = (const float*)(A_->ws + WS_SCT) + 2 * 32768;
        const float code = (dg[2] < 1e-3f ? 1.f : 2.f) * 10000.f + (dg[0] < 0.07f ? 1.f : 2.f) * 1000.f;
        A_->out[0] = code; }
#endif
#ifdef TIMING_MASK
    GRID_BAR(); STAMP(12);
    if (blockIdx.x == 0 && threadIdx.x == 0) { volatile LAS unsigned long long* tq = (volatile LAS unsigned long long*)((LAS unsigned char*)lds + LDSCTL_OFF + 64); unsigned long long s = 0;
        for (int p = 0; p < 13; ++p) if ((TIMING_MASK >> p) & 1) s += tq[1 + p];
        KArgsP T_ = (KArgsP)__builtin_amdgcn_kernarg_segment_ptr(); T_->out[0] = (float)s * TIMING_UNIT; }
#endif
}

extern "C" void kernel_launch(void* const* d_in, const int* in_sizes, int n_in, void* d_out, int out_size, void* d_ws, size_t ws_size, hipStream_t stream) {
    static int grid = 0;
    if (grid == 0) {
        int dev = 0, cus = 0, per_cu = 0;
        if (n_in != 32 || ws_size < WS_END) { fprintf(stderr, "kernel_launch: unexpected n_in %d / ws %zu\n", n_in, ws_size); grid = -1; return; }
        if (hipGetDevice(&dev) != hipSuccess || hipDeviceGetAttribute(&cus, hipDeviceAttributeMultiprocessorCount, dev) != hipSuccess) { grid = -1; return; }
        if (hipFuncSetAttribute((const void*)mk_fwd, hipFuncAttributeMaxDynamicSharedMemorySize, LDS_BYTES) != hipSuccess) { fprintf(stderr, "kernel_launch: hipFuncSetAttribute failed\n"); grid = -1; return; }
        if (hipOccupancyMaxActiveBlocksPerMultiprocessor(&per_cu, (const void*)mk_fwd, NWAVES * 64, LDS_BYTES) != hipSuccess || per_cu < 1) { fprintf(stderr, "kernel_launch: occupancy query says %d\n", per_cu); per_cu = 1; }
        (void)hipGetLastError();
        grid = cus;
    }
    if (grid < 0) return;
    (void)hipMemsetAsync((char*)d_ws + WS_CTL, 0, CTL_ZERO_BYTES, stream);
    Args a{};
    for (int i = 0; i < 32; ++i) a.in[i] = (const float*)d_in[i];
    a.out = (float*)d_out; a.ws = (unsigned char*)d_ws;
    void* kargs[] = {&a};
    hipError_t e = hipLaunchCooperativeKernel((const void*)mk_fwd, dim3(grid), dim3(NWAVES * 64), kargs, LDS_BYTES, stream);
    if (e != hipSuccess) fprintf(stderr, "kernel_launch: cooperative launch failed: %s (grid %d)\n", hipGetErrorString(e), grid);
}
```
